# Optimizing an MI355X kernel written in HIP

```python
import math
import jax, jax.numpy as jnp
from jax import lax
import numpy as np

D_MODEL = 4096
BATCH = 2
SEQ = 4096
DEPTH = 1

RET_HEADS = 8
RET_HEAD_DIM = 256
RET_WIDTH = RET_HEADS * RET_HEAD_DIM
SG_GROUPS = 8
SG_GROUP_DIM = 256
SG_WIDTH = SG_GROUPS * SG_GROUP_DIM
CHUNK = 128
D_FF = -(-8 * D_MODEL // (3 * 256)) * 256
IN_WIDTHS = (RET_WIDTH, RET_WIDTH, RET_WIDTH, RET_WIDTH,
             SG_WIDTH, SG_WIDTH,
             D_MODEL, D_MODEL)
IN_WIDTH = sum(IN_WIDTHS)
ROPE_BASE = 10000.0
LN_EPS = 1e-5
ALPHA = (2.0 * DEPTH) ** 0.25
BETA = (8.0 * DEPTH) ** -0.25
ADA_SCALE = 0.1

kernel_name = "hybrid_retention_gmlp_deepnorm_adaln"


def _split_cols(z, widths):
    outs, start = [], 0
    for w in widths:
        outs.append(z[..., start:start + w])
        start += w
    return outs


def _layer_norm(x, g, b):
    xf = x.astype(jnp.float32)
    mu = jnp.mean(xf, axis=-1, keepdims=True)
    var = jnp.mean(jnp.square(xf - mu), axis=-1, keepdims=True)
    y = (xf - mu) * lax.rsqrt(var + LN_EPS)
    return (y * g.astype(jnp.float32) + b.astype(jnp.float32)).astype(x.dtype)


def _norm_noaffine(xf):
    mu = jnp.mean(xf, axis=-1, keepdims=True)
    var = jnp.mean(jnp.square(xf - mu), axis=-1, keepdims=True)
    return (xf - mu) * lax.rsqrt(var + LN_EPS)


def _rotary(x, pos):
    d = x.shape[-1]
    inv_freq = ROPE_BASE ** (-jnp.arange(0, d, 2, dtype=jnp.float32) / d)
    ang = pos.astype(jnp.float32)[..., None] * inv_freq
    cos = jnp.cos(ang)[:, :, None, :]
    sin = jnp.sin(ang)[:, :, None, :]
    x1, x2 = x[..., : d // 2], x[..., d // 2:]
    return jnp.concatenate([x1 * cos - x2 * sin, x2 * cos + x1 * sin], axis=-1)


def _retention_chunkwise(q, k, v):
    B, S, H, d = q.shape
    n_chunks = S // CHUNK
    log_g = jnp.log(1.0 - 2.0 ** (-5.0 - jnp.arange(H, dtype=jnp.float32)))
    idx = jnp.arange(CHUNK, dtype=jnp.float32)
    diff = idx[:, None] - idx[None, :]
    causal = diff >= 0
    inner_decay = jnp.where(causal[None], jnp.exp(log_g[:, None, None] * jnp.maximum(diff, 0.0)[None]), 0.0)
    xi = jnp.exp(log_g[:, None] * (idx[None, :] + 1.0))
    zeta = jnp.exp(log_g[:, None] * (CHUNK - 1.0 - idx[None, :]))
    chunk_decay = jnp.exp(log_g * CHUNK)

    def to_chunks(t):
        return t.reshape(B, n_chunks, CHUNK, H, d).transpose(1, 0, 3, 2, 4)

    def step(R, inp):
        qc, kc, vc = inp
        scores = jnp.einsum('bhnd,bhmd->bhnm', qc, kc) * inner_decay[None]
        inner = jnp.einsum('bhnm,bhme->bhne', scores, vc)
        cross = jnp.einsum('bhnd,bhde->bhne', qc, R) * xi[None, :, :, None]
        R_new = chunk_decay[None, :, None, None] * R + jnp.einsum(
            'bhmd,bhme->bhde', kc * zeta[None, :, :, None], vc)
        return R_new, inner + cross

    R0 = jnp.zeros((B, H, d, v.shape[-1]), jnp.float32)
    _, ys = lax.scan(step, R0, (to_chunks(q), to_chunks(k), to_chunks(v)))
    return ys.transpose(1, 0, 3, 2, 4).reshape(B, S, H, v.shape[-1])


def _spatial_gating(u, s, ln_g, ln_b, w_s, b_s):
    B, S, _ = s.shape
    n_chunks = S // CHUNK
    s = _layer_norm(s, ln_g, ln_b)
    mask = jnp.tril(jnp.ones((CHUNK, CHUNK), dtype=bool))
    w = jnp.where(mask[None], w_s, jnp.zeros_like(w_s))
    sc = s.reshape(B, n_chunks, CHUNK, SG_GROUPS, SG_GROUP_DIM)
    mixed = jnp.einsum('gts,bnsgc->bntgc', w, sc) + b_s.T[None, None, :, :, None]
    return u * mixed.reshape(B, S, SG_WIDTH)


def setup_inputs(seed: int = 0) -> dict:
    key = jax.random.key(seed)
    ks = jax.random.split(key, 24)
    f32 = jnp.float32
    L, D = DEPTH, D_MODEL

    def nrm(k, shape, scale):
        return jax.random.normal(k, shape, f32) * scale

    x = jax.random.normal(ks[0], (BATCH, SEQ, D), f32)
    c = jax.random.normal(ks[1], (BATCH, D), f32)
    offset = jax.random.randint(ks[2], (BATCH,), 0, SEQ, dtype=jnp.int32)
    positions = (offset[:, None] + jnp.arange(SEQ, dtype=jnp.int32)[None, :]).astype(jnp.int32)
    return {
        "x": x,
        "c": c,
        "positions": positions,
        "w_ada": nrm(ks[3], (L, D, 6 * D), ADA_SCALE * D ** -0.5),
        "b_ada": nrm(ks[4], (L, 6 * D), 0.01),
        "w_in": nrm(ks[5], (L, D, IN_WIDTH), D ** -0.5),
        "sg_ln_g": 1.0 + nrm(ks[6], (L, SG_WIDTH), 0.01),
        "sg_ln_b": nrm(ks[7], (L, SG_WIDTH), 0.01),
        "sg_w": nrm(ks[8], (L, SG_GROUPS, CHUNK, CHUNK), CHUNK ** -0.5),
        "sg_b": 1.0 + nrm(ks[9], (L, SG_GROUPS, CHUNK), 0.01),
        "w_ret_up": nrm(ks[10], (L, RET_WIDTH, D), RET_WIDTH ** -0.5),
        "w_sg_up": nrm(ks[11], (L, SG_WIDTH, D), SG_WIDTH ** -0.5),
        "w_out": nrm(ks[12], (L, D, D), BETA * D ** -0.5),
        "ln1_g": 1.0 + nrm(ks[13], (L, D), 0.01),
        "ln1_b": nrm(ks[14], (L, D), 0.01),
        "w_gate_up": nrm(ks[15], (L, D, 2 * D_FF), D ** -0.5),
        "w_down": nrm(ks[16], (L, D_FF, D), BETA * D_FF ** -0.5),
        "ln2_g": 1.0 + nrm(ks[17], (L, D), 0.01),
        "ln2_b": nrm(ks[18], (L, D), 0.01),
    }


def reference(x, c, positions, w_ada, b_ada, w_in, sg_ln_g, sg_ln_b, sg_w, sg_b,
              w_ret_up, w_sg_up, w_out, ln1_g, ln1_b, w_gate_up, w_down, ln2_g, ln2_b):
    B, S, D = x.shape
    for l in range(DEPTH):
        ada = jax.nn.silu(c) @ w_ada[l] + b_ada[l]
        sh1, sc1, g1, sh2, sc2, g2 = [t[:, None, :] for t in jnp.split(ada, 6, axis=-1)]

        h = x * (1.0 + sc1) + sh1
        z = h @ w_in[l]
        q, k, v, g, u, s, gate_ret, gate_sg = _split_cols(z, IN_WIDTHS)

        qh = _rotary(q.reshape(B, S, RET_HEADS, RET_HEAD_DIM).astype(jnp.float32), positions)
        kh = _rotary(k.reshape(B, S, RET_HEADS, RET_HEAD_DIM).astype(jnp.float32), positions) * (RET_HEAD_DIM ** -0.5)
        vh = v.reshape(B, S, RET_HEADS, RET_HEAD_DIM).astype(jnp.float32)
        ret = _norm_noaffine(_retention_chunkwise(qh, kh, vh))
        ret = ret.reshape(B, S, RET_WIDTH).astype(x.dtype) * jax.nn.silu(g)
        y_ret = ret @ w_ret_up[l]

        sgu = _spatial_gating(jax.nn.gelu(u), jax.nn.gelu(s), sg_ln_g[l], sg_ln_b[l], sg_w[l], sg_b[l])
        y_sg = sgu @ w_sg_up[l]

        mix = jax.nn.sigmoid(gate_ret) * y_ret + jax.nn.sigmoid(gate_sg) * y_sg
        x = _layer_norm(ALPHA * x + (1.0 + g1) * (mix @ w_out[l]), ln1_g[l], ln1_b[l])

        h = x * (1.0 + sc2) + sh2
        a = h @ w_gate_up[l]
        ffn = (jax.nn.silu(a[..., :D_FF]) * a[..., D_FF:]) @ w_down[l]
        x = _layer_norm(ALPHA * x + (1.0 + g2) * ffn, ln2_g[l], ln2_b[l])
    return x
```

```cpp
#include <hip/hip_runtime.h>
#include <cstdio>
#include <cstdint>
constexpr int NWAVES = 8;
constexpr int BATCH = 2, SEQ = 4096, D = 4096, M = BATCH * SEQ;
constexpr int RW = 2048, NH = 8, HD = 256, SGW = 2048, NG = 8, GD = 256, CHK = 128, DFF = 11008, INW = 20480, ADAW = 6 * D;
constexpr float LN_EPS = 1e-5f;
constexpr float ALPHA = 1.189207115002721f;
#ifndef MK_N_LAUNCHES
#define MK_N_LAUNCHES 1
#endif
constexpr int N_PHASES = 11;

constexpr size_t MiB = 1u << 20;
constexpr size_t WS_CTL = 0, CTL_ZERO_BYTES = 1 * MiB;
constexpr size_t WS_COS = 1 * MiB, WS_SIN = 5 * MiB, WS_STATS = 9 * MiB;
constexpr size_t WS_WIN = 16 * MiB, WS_WRET = 176 * MiB, WS_WSG = 192 * MiB, WS_WOUT = 208 * MiB, WS_WGU = 240 * MiB, WS_WDN = 412 * MiB;
constexpr size_t WS_H = 498 * MiB, WS_Q = 562 * MiB, WS_K = 594 * MiB, WS_KT = 626 * MiB, WS_VT = 658 * MiB, WS_GS = 690 * MiB, WS_UG = 722 * MiB, WS_ST = 754 * MiB;
constexpr size_t WS_SIGR = 786 * MiB, WS_SIGS = 850 * MiB, WS_RET = 914 * MiB, WS_RETG = 978 * MiB, WS_SGU = 1010 * MiB, WS_MIX = 1042 * MiB, WS_PRE = 1106 * MiB, WS_X1 = 1234 * MiB;
constexpr size_t WS_ACT = 562 * MiB;
constexpr size_t WS_END = 1362 * MiB;
static_assert(WS_WGU + (size_t)2 * DFF * D * 2 <= WS_WDN && WS_WDN + (size_t)D * DFF * 2 <= WS_H && WS_ACT + (size_t)M * DFF * 2 <= WS_ST, "d_ws map");
constexpr int CW_BAR = 4096;
constexpr int CW_ADA = 65536;
static_assert((CW_ADA + 2 * ADAW) * 4 <= (int)CTL_ZERO_BYTES, "ctl");

constexpr int RING_OFF = 0, RING_BYTES = 131072;
constexpr int LDSCTL_OFF = RING_BYTES, MISC_OFF = LDSCTL_OFF + 320;
constexpr int LDS_BYTES = 147456;

namespace pg8 {
#define PG8_LAS __attribute__((address_space(3)))
typedef unsigned short bf16_t;
typedef short bf16x8 __attribute__((ext_vector_type(8)));
typedef float f32x4 __attribute__((ext_vector_type(4)));
typedef unsigned u32x4 __attribute__((ext_vector_type(4)));
constexpr int BM = 256, BK = 64, HALF = 128, HTB = HALF * BK * 2  , STAGE_BYTES = 8 * HTB, NXCD = 8, WGM = 8;

__host__ __device__ __forceinline__ int lds_byte(int r, int c) { const int st = (r >> 4) * 2 + (c >> 5), rr = r & 15, cc = c & 31, ob = rr * 64 + cc * 2; return st * 1024 + (ob ^ (((ob >> 9) & 1) << 5)); }
__host__ __device__ __forceinline__ void stage_rc(int b, int& R, int& C) { const int st = b / 1024, sb = b % 1024, swz = sb ^ (((sb >> 9) & 1) << 5); R = (st >> 1) * 16 + swz / 64; C = (st & 1) * 32 + (swz % 64) / 2; }
__host__ __device__ __forceinline__ int perm32(int rho) { const int n = rho >> 4, i = rho & 15; return 8 * (i >> 2) + 4 * n + (i & 3); }

struct Unit { int pm, pn; };
struct Gemm { const bf16_t* A; const bf16_t* Bt; int M, N, K; };

struct StaticOrder {
    int nM, nN, nwg, G, c;
    __host__ __device__ void init(int M, int N, int G_, int c_) { nM = M / BM; nN = N / BM; nwg = nM * nN; G = G_; c = c_; }
    __host__ __device__ bool next(int i, Unit& u) const {
        const long L = (long)i * G + c; if (L >= nwg) return false;
        int wgid = (int)L; { const int q = nwg / NXCD, r = nwg % NXCD, xcd = wgid % NXCD, off = wgid / NXCD; wgid = (xcd < r ? xcd * (q + 1) : r * (q + 1) + (xcd - r) * q) + off; }
        const int nig = WGM * nN, gid = wgid / nig, fm = gid * WGM, gsz = (nM - fm) < WGM ? (nM - fm) : WGM;
        u.pm = fm + ((wgid % nig) % gsz); u.pn = (wgid % nig) / gsz; return true;
    }
    __device__ __forceinline__ void a_ready(const Unit&) const {}
    __device__ __forceinline__ void done(const Unit&) const {}
};
typedef __bf16 bf16v2_t __attribute__((ext_vector_type(2)));
typedef float f32v2_t __attribute__((ext_vector_type(2)));
__device__ __forceinline__ unsigned cvt_pk_bf16(float lo, float hi) { const f32v2_t v = {lo, hi}; const bf16v2_t b = __builtin_convertvector(v, bf16v2_t); return __builtin_bit_cast(unsigned, b); }
typedef float f32x2 __attribute__((ext_vector_type(2)));
typedef unsigned u32x2 __attribute__((ext_vector_type(2)));
__device__ __forceinline__ float fast_sigmoid(float x) { return __builtin_amdgcn_rcpf(1.0f + __builtin_amdgcn_exp2f(-1.4426950408889634f * x)); }
__device__ __forceinline__ float fast_silu(float x) { return x * fast_sigmoid(x); }
__device__ __forceinline__ float gelu_tanh(float x) { const float y = 1.5957691216057308f * (x + 0.044715f * x * x * x); return x * fast_sigmoid(y); }
__device__ __forceinline__ float bf_lo(unsigned w) { return __uint_as_float(w << 16); }
__device__ __forceinline__ float bf_hi(unsigned w) { return __uint_as_float(w & 0xffff0000u); }

__device__ __forceinline__ float log2_gamma(int h) { const float xg = __builtin_amdgcn_exp2f(-5.0f - (float)h); const float x2 = xg * xg; return -1.4426950408889634f * (xg + x2 * 0.5f + x2 * xg * (1.0f / 3.0f) + x2 * x2 * 0.25f + x2 * x2 * xg * 0.2f); }
struct EpiZ {
    static constexpr bool PERM = true, AFTER_DRAIN = false;
    unsigned char* ws; float* stats; const float *cosT, *sinT;
    __device__ __forceinline__ void operator()(const f32x4 (&acc)[2][2][4][2], const Unit& u, int wr, int wc, int fr, int fq) const {
        const int pn = u.pn, row0 = u.pm * BM + wr * 64 + fr, cl = wc * 32 + 8 * fq;
        if (pn < 16) {
            const int h = pn & 7; const bool isk = pn >= 8;
            const float l2g = log2_gamma(h);
            bf16_t* dst = (bf16_t*)(ws + (isk ? WS_K : WS_Q));
#pragma unroll
            for (int ai = 0; ai < 2; ++ai)
#pragma unroll
                for (int m = 0; m < 4; ++m) {
                    const int r = row0 + ai * HALF + m * 16, nloc = r & 127;
                    const float sc = isk ? 0.0625f * __builtin_amdgcn_exp2f(-(float)nloc * l2g) : __builtin_amdgcn_exp2f((float)nloc * l2g);
                    const float* cp = cosT + (size_t)r * 128 + cl; const float* sp = sinT + (size_t)r * 128 + cl;
                    const f32x4 c0 = *(const f32x4*)cp, c1 = *(const f32x4*)(cp + 4), s0 = *(const f32x4*)sp, s1 = *(const f32x4*)(sp + 4);
                    const f32x4 xa = acc[ai][0][m][0], xb = acc[ai][0][m][1], ya = acc[ai][1][m][0], yb = acc[ai][1][m][1];
                    const f32x4 o1a = (xa * c0 - ya * s0) * sc, o1b = (xb * c1 - yb * s1) * sc, o2a = (ya * c0 + xa * s0) * sc, o2b = (yb * c1 + xb * s1) * sc;
                    u32x4 w1, w2; w1.x = cvt_pk_bf16(o1a[0], o1a[1]); w1.y = cvt_pk_bf16(o1a[2], o1a[3]); w1.z = cvt_pk_bf16(o1b[0], o1b[1]); w1.w = cvt_pk_bf16(o1b[2], o1b[3]);
                    w2.x = cvt_pk_bf16(o2a[0], o2a[1]); w2.y = cvt_pk_bf16(o2a[2], o2a[3]); w2.z = cvt_pk_bf16(o2b[0], o2b[1]); w2.w = cvt_pk_bf16(o2b[2], o2b[3]);
                    bf16_t* rowp = dst + (size_t)r * 2048 + 256 * h + cl;
                    *(u32x4*)rowp = w1; *(u32x4*)(rowp + 128) = w2;
                    if (isk) {
                        bf16_t* t1 = (bf16_t*)(ws + WS_KT) + (size_t)(256 * h + cl) * 8192 + r; bf16_t* t2 = t1 + (size_t)128 * 8192;
#pragma unroll
                        for (int q = 0; q < 4; ++q) { const unsigned a = w1[q], b = w2[q];
                            t1[(size_t)(2 * q) * 8192] = (bf16_t)(a & 0xffffu); t1[(size_t)(2 * q + 1) * 8192] = (bf16_t)(a >> 16);
                            t2[(size_t)(2 * q) * 8192] = (bf16_t)(b & 0xffffu); t2[(size_t)(2 * q + 1) * 8192] = (bf16_t)(b >> 16); }
                    }
                    asm volatile("" ::: "memory");
                }
        } else if (pn < 24 || (pn >= 40 && pn < 48)) {
            const bool iss = pn >= 40; bf16_t* T = (bf16_t*)(ws + (iss ? WS_ST : WS_VT)); const int ct = (iss ? pn - 40 : pn - 16) * 256;
#pragma unroll
            for (int ai = 0; ai < 2; ++ai)
#pragma unroll
                for (int m = 0; m < 4; ++m) {
                    const int r = row0 + ai * HALF + m * 16; float sum = 0.f, sq = 0.f;
#pragma unroll
                    for (int bj = 0; bj < 2; ++bj)
#pragma unroll
                        for (int n = 0; n < 2; ++n) {
                            f32x4 v = acc[ai][bj][m][n];
                            if (iss) { v[0] = gelu_tanh(v[0]); v[1] = gelu_tanh(v[1]); v[2] = gelu_tanh(v[2]); v[3] = gelu_tanh(v[3]); }
                            const unsigned a = cvt_pk_bf16(v[0], v[1]), b = cvt_pk_bf16(v[2], v[3]);
                            if (iss) { const float f0 = bf_lo(a), f1 = bf_hi(a), f2 = bf_lo(b), f3 = bf_hi(b); sum += (f0 + f1) + (f2 + f3); sq += (f0 * f0 + f1 * f1) + (f2 * f2 + f3 * f3); }
                            bf16_t* t = T + (size_t)(ct + bj * HALF + cl + 4 * n) * 8192 + r;
                            t[0] = (bf16_t)(a & 0xffffu); t[8192] = (bf16_t)(a >> 16); t[2 * 8192] = (bf16_t)(b & 0xffffu); t[3 * 8192] = (bf16_t)(b >> 16);
                        }
                    if (iss) {
                        sum += __shfl_xor(sum, 16); sum += __shfl_xor(sum, 32); sq += __shfl_xor(sq, 16); sq += __shfl_xor(sq, 32);
                        if (fq == 0) { f32x2 o; o.x = sum; o.y = sq; *(f32x2*)(stats + (size_t)r * 64 + ((pn - 40) * 4 + wc) * 2) = o; }
                    }
                    asm volatile("" ::: "memory");
                }
        } else {
            const int kind = pn < 32 ? 0 : (pn < 40 ? 1 : 2);
            size_t doff; int ldc, ct;
            if (pn < 32) { doff = WS_GS; ldc = 2048; ct = (pn - 24) * 256; } else if (pn < 40) { doff = WS_UG; ldc = 2048; ct = (pn - 32) * 256; }
            else if (pn < 64) { doff = WS_SIGR; ldc = 4096; ct = (pn - 48) * 256; } else { doff = WS_SIGS; ldc = 4096; ct = (pn - 64) * 256; }
            bf16_t* dst = (bf16_t*)(ws + doff);
#pragma unroll
            for (int ai = 0; ai < 2; ++ai)
#pragma unroll
                for (int m = 0; m < 4; ++m) {
                    const int r = row0 + ai * HALF + m * 16; bf16_t* rowp = dst + (size_t)r * ldc + ct + cl;
#pragma unroll
                    for (int bj = 0; bj < 2; ++bj) {
                        f32x4 v0 = acc[ai][bj][m][0], v1 = acc[ai][bj][m][1];
#pragma unroll
                        for (int j = 0; j < 4; ++j) {
                            if (kind == 0) { v0[j] = fast_silu(v0[j]); v1[j] = fast_silu(v1[j]); }
                            else if (kind == 1) { v0[j] = gelu_tanh(v0[j]); v1[j] = gelu_tanh(v1[j]); }
                            else { v0[j] = fast_sigmoid(v0[j]); v1[j] = fast_sigmoid(v1[j]); } }
                        u32x4 w; w.x = cvt_pk_bf16(v0[0], v0[1]); w.y = cvt_pk_bf16(v0[2], v0[3]); w.z = cvt_pk_bf16(v1[0], v1[1]); w.w = cvt_pk_bf16(v1[2], v1[3]);
                        *(u32x4*)(rowp + bj * HALF) = w; }
                }
        }
    }
};

struct EpiSwiGLU {
    static constexpr bool PERM = true, AFTER_DRAIN = false;
    bf16_t* O; int ldc;
    __device__ __forceinline__ void operator()(const f32x4 (&acc)[2][2][4][2], const Unit& u, int wr, int wc, int fr, int fq) const {
        const int row0 = u.pm * BM + wr * 64 + fr, col0 = u.pn * HALF + wc * 32 + 8 * fq;
#pragma unroll
        for (int ai = 0; ai < 2; ++ai)
#pragma unroll
            for (int m = 0; m < 4; ++m) {
                const f32x4 g0 = acc[ai][0][m][0], g1 = acc[ai][0][m][1], u0 = acc[ai][1][m][0], u1 = acc[ai][1][m][1]; f32x4 v0, v1;
#pragma unroll
                for (int j = 0; j < 4; ++j) { v0[j] = fast_silu(g0[j]) * u0[j]; v1[j] = fast_silu(g1[j]) * u1[j]; }
                u32x4 w; w.x = cvt_pk_bf16(v0[0], v0[1]); w.y = cvt_pk_bf16(v0[2], v0[3]); w.z = cvt_pk_bf16(v1[0], v1[1]); w.w = cvt_pk_bf16(v1[2], v1[3]);
                *(u32x4*)(O + (size_t)(row0 + ai * HALF + m * 16) * ldc + col0) = w; }
    }
};

template <int MODE> struct EpiMix {
    static constexpr bool PERM = false, AFTER_DRAIN = false;
    const bf16_t* gate; float* T; bf16_t* O; int ldc;
    __device__ __forceinline__ void operator()(const f32x4 (&acc)[2][2][4][2], const Unit& u, int wr, int wc, int fr, int fq) const {
        const int row0 = u.pm * BM + wr * 64 + fr, col0 = u.pn * BM + wc * 32 + 4 * fq;
#pragma unroll
        for (int ai = 0; ai < 2; ++ai)
#pragma unroll
            for (int m = 0; m < 4; ++m) { const size_t off = (size_t)(row0 + ai * HALF + m * 16) * ldc + col0;
#pragma unroll
                for (int bj = 0; bj < 2; ++bj)
#pragma unroll
                    for (int n = 0; n < 2; ++n) { const size_t o = off + bj * HALF + n * 16;
                        const u32x2 gw = *(const u32x2*)(gate + o); const f32x4 gv = (f32x4){bf_lo(gw.x), bf_hi(gw.x), bf_lo(gw.y), bf_hi(gw.y)};
                        if (MODE == 0) { *(f32x4*)(T + o) = gv * acc[ai][bj][m][n]; }
                        else { const f32x4 v = *(const f32x4*)(T + o) + gv * acc[ai][bj][m][n]; u32x2 w; w.x = cvt_pk_bf16(v[0], v[1]); w.y = cvt_pk_bf16(v[2], v[3]); *(u32x2*)(O + o) = w; } } }
    }
};

struct EpiRes {
    static constexpr bool PERM = false, AFTER_DRAIN = false;
    const float* res; float* P; int ldc; const float* ga; const float* gb; int ga_stride; int rows_per_batch; float alpha;
    __device__ __forceinline__ void operator()(const f32x4 (&acc)[2][2][4][2], const Unit& u, int wr, int wc, int fr, int fq) const {
        const int row0 = u.pm * BM + wr * 64 + fr, col0 = u.pn * BM + wc * 32 + 4 * fq; const int b = (u.pm * BM) / rows_per_batch;
        f32x4 gv[2][2];
#pragma unroll
        for (int bj = 0; bj < 2; ++bj)
#pragma unroll
            for (int n = 0; n < 2; ++n) gv[bj][n] = *(const f32x4*)(ga + (size_t)b * ga_stride + col0 + bj * HALF + n * 16) + *(const f32x4*)(gb + col0 + bj * HALF + n * 16) + 1.0f;
#pragma unroll
        for (int ai = 0; ai < 2; ++ai)
#pragma unroll
            for (int m = 0; m < 4; ++m) { const size_t off = (size_t)(row0 + ai * HALF + m * 16) * ldc + col0;
#pragma unroll
                for (int bj = 0; bj < 2; ++bj)
#pragma unroll
                    for (int n = 0; n < 2; ++n) { const size_t o = off + bj * HALF + n * 16;
                        *(f32x4*)(P + o) = *(const f32x4*)(res + o) * alpha + gv[bj][n] * acc[ai][bj][m][n]; } }
    }
};

template <class Epi, class Sched, bool ALIGN_EPI = false, bool SP2 = false>
__device__ __forceinline__ void gemm_phase(PG8_LAS unsigned char* lds, const Gemm g, const Sched& S, const Epi& E) {
    const int tid = threadIdx.x, wid = __builtin_amdgcn_readfirstlane(tid >> 6), lane = tid & 63, wr = wid >> 2, wc = wid & 3, fr = lane & 15, fq = lane >> 4;
    const int K = g.K, nt = K / BK;
    unsigned voffA[2], voffB[2];
#pragma unroll
    for (int i = 0; i < 2; ++i) { int R, C; stage_rc(tid * 16 + i * 8192, R, C); const int Rb = Epi::PERM ? ((R & ~31) + perm32(R & 31)) : R;
        voffA[i] = (unsigned)(R * K + C) * 2u; voffB[i] = (unsigned)(Rb * K + C) * 2u; }
    const size_t kstep = (size_t)(BK * 2);
    const size_t hstep = (size_t)HALF * K * 2;
    const size_t tstep = 2 * hstep;
    const unsigned ldsw = (unsigned)wid * 1024u;
    const int aoff = lds_byte(wr * 64 + fr, fq * 8), boff = lds_byte(wc * 32 + fr, fq * 8);
#define PG8_SA(b, h) (((b) * 2 + (h)) * HTB)
#define PG8_SB(b, h) ((4 + (b) * 2 + (h)) * HTB)
#define PG8_STAGE(bufoff, gbase, voff) do { _Pragma("unroll") for (int _i = 0; _i < 2; ++_i) \
        __builtin_amdgcn_global_load_lds((const unsigned*)((const char*)(gbase) + (voff)[_i]), (PG8_LAS unsigned*)(lds + (bufoff) + ldsw + _i * 8192), 16, 0, 0); } while (0)
#define PG8_LDA(dst, b, h) do { _Pragma("unroll") for (int m = 0; m < 4; ++m) _Pragma("unroll") for (int k = 0; k < 2; ++k) dst[m][k] = *(const PG8_LAS bf16x8*)(lds + PG8_SA(b, h) + aoff + m * 2048 + k * 1024); } while (0)
#define PG8_LDB(dst, b, h) do { _Pragma("unroll") for (int n = 0; n < 2; ++n) _Pragma("unroll") for (int k = 0; k < 2; ++k) dst[n][k] = *(const PG8_LAS bf16x8*)(lds + PG8_SB(b, h) + boff + n * 2048 + k * 1024); } while (0)
#define PG8_MMA(ai, bj, At, Bt) do { __builtin_amdgcn_s_setprio(1); _Pragma("unroll") for (int m = 0; m < 4; ++m) _Pragma("unroll") for (int n = 0; n < 2; ++n) _Pragma("unroll") for (int k = 0; k < 2; ++k) \
        acc[ai][bj][m][n] = __builtin_amdgcn_mfma_f32_16x16x32_bf16(Bt[n][k], At[m][k], acc[ai][bj][m][n], 0, 0, 0); __builtin_amdgcn_s_setprio(0); } while (0)
#define PG8_WAIT_V(n) asm volatile("s_waitcnt vmcnt(" #n ")" ::: "memory")
#define PG8_WAIT_L(n) asm volatile("s_waitcnt lgkmcnt(" #n ")" ::: "memory")
#define PG8_BAR __builtin_amdgcn_s_barrier()
#define PG8_SCHED __builtin_amdgcn_sched_barrier(0)
    Unit cur, nxt; int ui = 0;
    if (!S.next(0, cur)) return;
    f32x4 acc[2][2][4][2];
#pragma unroll
    for (int a = 0; a < 2; ++a)
#pragma unroll
        for (int b = 0; b < 2; ++b)
#pragma unroll
            for (int m = 0; m < 4; ++m)
#pragma unroll
                for (int n = 0; n < 2; ++n) acc[a][b][m][n] = (f32x4){0.f, 0.f, 0.f, 0.f};
    bf16x8 At[4][2], B0[2][2], B1[2][2];
    const char* cA = (const char*)g.A + (size_t)cur.pm * tstep; const char* cB = (const char*)g.Bt + (size_t)cur.pn * tstep;
    S.a_ready(cur);
    if constexpr (SP2) {
        PG8_STAGE(PG8_SB(0, 0), cB, voffB); PG8_STAGE(PG8_SB(0, 1), cB + hstep, voffB); PG8_STAGE(PG8_SA(0, 0), cA, voffA); PG8_STAGE(PG8_SA(0, 1), cA + hstep, voffA);
        if (wr == 1) PG8_BAR;
        PG8_WAIT_V(2); PG8_BAR;
        PG8_STAGE(PG8_SB(1, 0), cB + kstep, voffB); PG8_STAGE(PG8_SA(1, 0), cA + kstep, voffA); PG8_STAGE(PG8_SB(1, 1), cB + hstep + kstep, voffB);
        PG8_WAIT_V(6); PG8_BAR;
    } else {
        PG8_STAGE(PG8_SB(0, 0), cB, voffB); PG8_STAGE(PG8_SA(0, 0), cA, voffA); PG8_STAGE(PG8_SB(0, 1), cB + hstep, voffB); PG8_STAGE(PG8_SA(0, 1), cA + hstep, voffA);
        if (wr == 1) PG8_BAR;
        PG8_WAIT_V(4); PG8_BAR;
        PG8_STAGE(PG8_SB(1, 0), cB + kstep, voffB); PG8_STAGE(PG8_SA(1, 0), cA + kstep, voffA); PG8_STAGE(PG8_SB(1, 1), cB + hstep + kstep, voffB);
        PG8_WAIT_V(6); PG8_BAR;
    }
    for (;;) {
        const bool has_next = S.next(ui + 1, nxt);
        const char* nA = has_next ? (const char*)g.A + (size_t)nxt.pm * tstep : cA; const char* nB = has_next ? (const char*)g.Bt + (size_t)nxt.pn * tstep : cB;
        for (int t = 0; t < nt; t += 2) {
            const bool last = (t == nt - 2);
            const char* a1 = cA + (size_t)(t + 1) * kstep;
            const char* a2 = last ? nA : cA + (size_t)(t + 2) * kstep; const char* b2 = last ? nB : cB + (size_t)(t + 2) * kstep;
            const char* a3 = a2 + kstep; const char* b3 = b2 + kstep;
            if (last && has_next) S.a_ready(nxt);
            if constexpr (SP2) {
            PG8_LDB(B0, 0, 0); PG8_LDB(B1, 0, 1); PG8_SCHED; PG8_LDA(At, 0, 0); PG8_STAGE(PG8_SA(1, 1), a1 + hstep, voffA);
            PG8_WAIT_V(8); PG8_WAIT_L(0); PG8_BAR; PG8_MMA(0, 0, At, B0); PG8_MMA(0, 1, At, B1); PG8_BAR; PG8_SCHED;
            PG8_LDA(At, 0, 1); PG8_STAGE(PG8_SB(0, 0), b2, voffB); PG8_STAGE(PG8_SB(0, 1), b2 + hstep, voffB); PG8_STAGE(PG8_SA(0, 0), a2, voffA);
            PG8_WAIT_V(8); PG8_WAIT_L(0); PG8_BAR; PG8_MMA(1, 0, At, B0); PG8_MMA(1, 1, At, B1); PG8_BAR; PG8_SCHED;
            PG8_LDB(B0, 1, 0); PG8_LDB(B1, 1, 1); PG8_SCHED; PG8_LDA(At, 1, 0); PG8_STAGE(PG8_SA(0, 1), a2 + hstep, voffA);
            PG8_WAIT_V(8); PG8_WAIT_L(0); PG8_BAR; PG8_MMA(0, 0, At, B0); PG8_MMA(0, 1, At, B1); PG8_BAR; PG8_SCHED;
            PG8_LDA(At, 1, 1); PG8_STAGE(PG8_SB(1, 0), b3, voffB); PG8_STAGE(PG8_SB(1, 1), b3 + hstep, voffB); PG8_STAGE(PG8_SA(1, 0), a3, voffA);
            PG8_WAIT_V(8); PG8_WAIT_L(0); PG8_BAR; PG8_MMA(1, 0, At, B0); PG8_MMA(1, 1, At, B1); PG8_BAR; PG8_SCHED;
            } else {
            PG8_LDB(B0, 0, 0); PG8_SCHED; PG8_LDA(At, 0, 0); PG8_STAGE(PG8_SA(1, 1), a1 + hstep, voffA);
            PG8_WAIT_L(8); PG8_BAR; PG8_WAIT_L(0); PG8_MMA(0, 0, At, B0); PG8_BAR; PG8_SCHED;
            PG8_LDB(B1, 0, 1); PG8_STAGE(PG8_SB(0, 0), b2, voffB);
            PG8_BAR; PG8_WAIT_L(0); PG8_MMA(0, 1, At, B1); PG8_BAR;
            PG8_LDA(At, 0, 1); PG8_STAGE(PG8_SA(0, 0), a2, voffA);
            PG8_BAR; PG8_WAIT_L(0); PG8_MMA(1, 0, At, B0); PG8_BAR; PG8_SCHED;
            PG8_STAGE(PG8_SB(0, 1), b2 + hstep, voffB);
            PG8_WAIT_V(6); PG8_BAR; PG8_MMA(1, 1, At, B1); PG8_BAR;
            PG8_LDB(B0, 1, 0); PG8_SCHED; PG8_LDA(At, 1, 0); PG8_STAGE(PG8_SA(0, 1), a2 + hstep, voffA);
            PG8_WAIT_L(8); PG8_BAR; PG8_WAIT_L(0); PG8_MMA(0, 0, At, B0); PG8_BAR; PG8_SCHED;
            PG8_LDB(B1, 1, 1); PG8_STAGE(PG8_SB(1, 0), b3, voffB);
            PG8_BAR; PG8_WAIT_L(0); PG8_MMA(0, 1, At, B1); PG8_BAR;
            PG8_LDA(At, 1, 1); PG8_STAGE(PG8_SA(1, 0), a3, voffA);
            PG8_BAR; PG8_WAIT_L(0); PG8_MMA(1, 0, At, B0); PG8_BAR; PG8_SCHED;
            PG8_STAGE(PG8_SB(1, 1), b3 + hstep, voffB);
            PG8_WAIT_V(6); PG8_BAR; PG8_MMA(1, 1, At, B1); PG8_BAR;
            }
        }
        if constexpr (ALIGN_EPI) { if (wr == 0) PG8_BAR; }
        if constexpr (!Epi::AFTER_DRAIN) { E(acc, cur, wr, wc, fr, fq); S.done(cur); }
        if (!has_next) break;
#pragma unroll
        for (int a = 0; a < 2; ++a)
#pragma unroll
            for (int b = 0; b < 2; ++b)
#pragma unroll
                for (int m = 0; m < 4; ++m)
#pragma unroll
                    for (int n = 0; n < 2; ++n) acc[a][b][m][n] = (f32x4){0.f, 0.f, 0.f, 0.f};
        cur = nxt; cA = nA; cB = nB; ++ui;
        if constexpr (ALIGN_EPI) { if (wr == 1) PG8_BAR; }
    }
    PG8_WAIT_V(0);
    if constexpr (!ALIGN_EPI) { if (wr == 0) PG8_BAR; }
    PG8_BAR;
    if constexpr (Epi::AFTER_DRAIN) { E.fused(acc, cur, wr, wc, fr, fq, lds, wid, lane); S.done(cur); }
#undef PG8_SA
#undef PG8_SB
#undef PG8_STAGE
#undef PG8_LDA
#undef PG8_LDB
#undef PG8_MMA
#undef PG8_WAIT_V
#undef PG8_WAIT_L
#undef PG8_BAR
#undef PG8_SCHED
}
}
#define GAS __attribute__((address_space(1)))
#define LAS __attribute__((address_space(3)))
typedef unsigned short bf16;
typedef unsigned v4u __attribute__((ext_vector_type(4)));
typedef float f32x4 __attribute__((ext_vector_type(4)));
typedef short bf16x8 __attribute__((ext_vector_type(8)));
typedef GAS unsigned gu32;
typedef GAS unsigned long long gu64;
#define RLX_AGENT __ATOMIC_RELAXED, __HIP_MEMORY_SCOPE_AGENT
#define LDS_WAIT() asm volatile("s_waitcnt lgkmcnt(0)" ::: "memory")
#define VM_WAIT() asm volatile("s_waitcnt vmcnt(0)" ::: "memory")
__device__ __forceinline__ unsigned long long rt() { return __builtin_amdgcn_s_memrealtime(); }
__device__ __forceinline__ unsigned f2bf(float f) { unsigned u = __builtin_bit_cast(unsigned, f); return (u + 0x7fffu + ((u >> 16) & 1u)) >> 16; }
__device__ __forceinline__ unsigned pk2(float lo, float hi) { return f2bf(lo) | (f2bf(hi) << 16); }
#define XB_TMO      128
#define XB_XCNT(j)  (256  + 64 * (j))
#define XB_XSUB(j)  (1280 + 64 * (j))
#define XB_XGEN(j)  (2304 + 64 * (j))
#define XB_TOP      3328
#define XB_TOPGEN   3392
#define XCD_BAR_WORDS 3456
#define XB_SPIN_CAP (1u << 18)

__device__ __forceinline__ unsigned xb_ld(unsigned* p)              { return __hip_atomic_load(p, __ATOMIC_RELAXED, __HIP_MEMORY_SCOPE_AGENT); }
__device__ __forceinline__ unsigned xb_add(unsigned* p, unsigned v) { return __hip_atomic_fetch_add(p, v, __ATOMIC_RELAXED, __HIP_MEMORY_SCOPE_AGENT); }
__device__ __forceinline__ unsigned xb_xcc_id() { return (unsigned)__builtin_amdgcn_s_getreg((3 << 11) | 20) & 0xFu; }
#define XB_SPIN(cond, bar) do { unsigned _sp = 0; while (cond) { __builtin_amdgcn_s_sleep(1); \
    if ((++_sp & 255u) == 0u) { if (xb_ld(&(bar)[XB_TMO])) break; if (_sp > XB_SPIN_CAP) { atomicAdd(&(bar)[XB_TMO], 1u); break; } } } } while (0)

struct XcdBarrier {
    unsigned* bar; unsigned x;
    volatile LAS unsigned* st;
};

__device__ __forceinline__ XcdBarrier xcd_barrier_post(unsigned* bar, volatile LAS unsigned* st) {
    XcdBarrier b; b.bar = bar; b.x = xb_xcc_id(); b.st = st;
    if (threadIdx.x == 0) (void)xb_add(&bar[XB_XCNT(b.x)], 1u);
    return b;
}
__device__ __forceinline__ void xcd_barrier_complete(unsigned* bar, unsigned x, unsigned& nloc, unsigned& nx) {
    const unsigned G = gridDim.x * gridDim.y * gridDim.z;
    unsigned sum, cnt, mine, sp = 0u;
    for (;;) {
        sum = 0u; cnt = 0u; mine = 0u;
#pragma unroll
        for (unsigned j = 0; j < 16; ++j) { const unsigned c = xb_ld(&bar[XB_XCNT(j)]); sum += c; cnt += (c > 0u) ? 1u : 0u; mine = (j == x) ? c : mine; }
        if (sum == G) break;
        __builtin_amdgcn_s_sleep(1);
        if ((++sp & 255u) == 0u) { if (xb_ld(&bar[XB_TMO])) break; if (sp > XB_SPIN_CAP) { atomicAdd(&bar[XB_TMO], 1u); break; } }
    }
    nloc = mine > 0u ? mine : 1u; nx = cnt > 0u ? cnt : 1u;
}

__device__ __forceinline__ void xcd_barrier(const XcdBarrier& b) {
    asm volatile("s_waitcnt vmcnt(0)" ::: "memory");
    __syncthreads();
    if (threadIdx.x == 0) {
        unsigned* bar = b.bar;
        __builtin_amdgcn_s_waitcnt(0);
        unsigned nloc = b.st[0], nx = b.st[1];
        if (nloc == 0u) { xcd_barrier_complete(bar, b.x, nloc, nx); b.st[0] = nloc; b.st[1] = nx; }
        const unsigned old = xb_add(&bar[XB_XSUB(b.x)], 1u);
        const unsigned gen = old / nloc;
        if (old + 1u == (gen + 1u) * nloc) {
            __builtin_amdgcn_fence(__ATOMIC_RELEASE, "agent");
            asm volatile("s_waitcnt vmcnt(0)" ::: "memory");
            const unsigned og = xb_add(&bar[XB_TOP], 1u);
            const unsigned tg = og / nx;
            if (og + 1u == (tg + 1u) * nx) xb_add(&bar[XB_TOPGEN], 1u);
            else XB_SPIN(xb_ld(&bar[XB_TOPGEN]) == tg, bar);
            __builtin_amdgcn_fence(__ATOMIC_ACQUIRE, "agent");
            xb_add(&bar[XB_XGEN(b.x)], 1u);
            asm volatile("s_waitcnt vmcnt(0)" ::: "memory");
        } else {
            XB_SPIN(xb_ld(&bar[XB_XGEN(b.x)]) == gen, bar);
            __builtin_amdgcn_fence(__ATOMIC_ACQUIRE, "agent");
            asm volatile("s_waitcnt vmcnt(0)" ::: "memory");
        }
    }
    __syncthreads();
}

typedef unsigned u32x2 __attribute__((ext_vector_type(2)));
typedef float f32x2 __attribute__((ext_vector_type(2)));
#define MFMA16(a, b, c) __builtin_amdgcn_mfma_f32_16x16x32_bf16((a), (b), (c), 0, 0, 0)
__device__ __forceinline__ float wave_sum(float v) {
#pragma unroll
    for (int o = 1; o < 64; o <<= 1) v += __shfl_xor(v, o);
    return v;
}
__device__ __forceinline__ float bflo(unsigned w) { return __uint_as_float(w << 16); }
__device__ __forceinline__ float bfhi(unsigned w) { return __uint_as_float(w & 0xffff0000u); }
__device__ __forceinline__ unsigned pkbf(float lo, float hi) { return pg8::cvt_pk_bf16(lo, hi); }

struct Args { const float* in[19]; float* out; unsigned char* ws; int ph_lo, ph_hi; };

__device__ __forceinline__ void p0_transpose_item(const float* W, int K, int N, bf16* WT, int kb, int n0, int row0, int lane) {
    const GAS float* src = (const GAS float*)W + (size_t)(kb * 64) * N + n0 + lane;
    float v[64];
#pragma unroll
    for (int i = 0; i < 64; ++i) v[i] = src[(size_t)i * N];
    GAS v4u* dst = (GAS v4u*)((GAS bf16*)WT + (size_t)(row0 + lane) * K + kb * 64);
#pragma unroll
    for (int c = 0; c < 8; ++c) { v4u o; o.x = pkbf(v[8 * c], v[8 * c + 1]); o.y = pkbf(v[8 * c + 2], v[8 * c + 3]); o.z = pkbf(v[8 * c + 4], v[8 * c + 5]); o.w = pkbf(v[8 * c + 6], v[8 * c + 7]); dst[c] = o; }
}
__device__ __forceinline__ int gu_row0(int n0) {
    const int up = n0 >= DFF ? 1 : 0, j = n0 - up * DFF; return 256 * (j >> 7) + 128 * up + (j & 127);
}

template <int MODE> __device__ __forceinline__ void row_pass(int gw, int NGW, int lane, const float* src, const float* lg, const float* lb, float* Y, bf16* H,
                                                             const float* ada, const float* bada, int seg_sh, int seg_sc) {
    for (int row = gw; row < M; row += NGW) {
        const int b = row / SEQ;
        const GAS f32x4* sp = (const GAS f32x4*)(src + (size_t)row * D) + lane;
        f32x4 v[16];
#pragma unroll
        for (int j = 0; j < 16; ++j) v[j] = sp[64 * j];
        if (MODE != 0) {
            float s = 0.f;
#pragma unroll
            for (int j = 0; j < 16; ++j) s += (v[j].x + v[j].y) + (v[j].z + v[j].w);
            const float mean = wave_sum(s) * (1.f / D); float s2 = 0.f;
#pragma unroll
            for (int j = 0; j < 16; ++j) { v[j] = v[j] - mean; s2 += (v[j].x * v[j].x + v[j].y * v[j].y) + (v[j].z * v[j].z + v[j].w * v[j].w); }
            const float rstd = 1.0f / sqrtf(wave_sum(s2) * (1.f / D) + LN_EPS);
            GAS f32x4* yp = (GAS f32x4*)(Y + (size_t)row * D) + lane;
#pragma unroll
            for (int j = 0; j < 16; ++j) { const f32x4 gg = ((const GAS f32x4*)lg)[lane + 64 * j], bb = ((const GAS f32x4*)lb)[lane + 64 * j]; v[j] = v[j] * rstd * gg + bb; yp[64 * j] = v[j]; }
        }
        if (MODE != 2) {
            const GAS f32x4* ash = (const GAS f32x4*)(ada + (size_t)b * ADAW + seg_sh * D) + lane; const GAS f32x4* bsh = (const GAS f32x4*)(bada + seg_sh * D) + lane;
            const GAS f32x4* asc = (const GAS f32x4*)(ada + (size_t)b * ADAW + seg_sc * D) + lane; const GAS f32x4* bsc = (const GAS f32x4*)(bada + seg_sc * D) + lane;
            GAS u32x2* hp = (GAS u32x2*)(H + (size_t)row * D) + lane;
#pragma unroll
            for (int j = 0; j < 16; ++j) { const f32x4 sh = ash[64 * j] + bsh[64 * j], sc = asc[64 * j] + bsc[64 * j] + 1.0f; const f32x4 o = v[j] * sc + sh;
                u32x2 w; w.x = pkbf(o.x, o.y); w.y = pkbf(o.z, o.w); hp[64 * j] = w; }
        }
    }
}

__device__ __forceinline__ void ret_unit(LAS unsigned char* lds, int tid, int lane, int wave, int bh, int es, const bf16* Q, const bf16* K, const bf16* KT, const bf16* VT, float* RET) {
    constexpr int KL_OFF = 0, KL_PITCH = 528, PL_OFF = 128 * KL_PITCH, PL_PITCH = 272, PL_WAVE = 16 * PL_PITCH, RL_OFF = PL_OFF + 8 * PL_WAVE, RL_PITCH = 528;
    static_assert(RL_OFF + 16 * RL_PITCH <= RING_BYTES, "retention LDS");
    const int b = bh >> 3, h = bh & 7, e0 = es * 16, i = lane & 15, g = lane >> 4, rb = wave;
    const float l2g = pg8::log2_gamma(h);
    const float gam = __builtin_amdgcn_exp2f(l2g), g127 = __builtin_amdgcn_exp2f(127.0f * l2g), g128 = __builtin_amdgcn_exp2f(128.0f * l2g);
    const GAS bf16* Qp = (const GAS bf16*)Q + (size_t)(b * SEQ) * RW + 256 * h;
    const GAS bf16* Kp = (const GAS bf16*)K + (size_t)(b * SEQ) * RW + 256 * h;
    const GAS bf16* KTp = (const GAS bf16*)KT + (size_t)(256 * h) * M + b * SEQ;
    const GAS bf16* VTp = (const GAS bf16*)VT + (size_t)(256 * h + e0) * M + b * SEQ;
    GAS float* Rp = (GAS float*)RET + (size_t)(b * SEQ) * RW + 256 * h + e0;
    for (int u = tid; u < 16 * RL_PITCH / 4; u += NWAVES * 64) ((LAS unsigned*)(lds + RL_OFF))[u] = 0u;
    f32x4 st[2]; st[0] = (f32x4){0.f, 0.f, 0.f, 0.f}; st[1] = st[0];
    v4u kreg[8];
#pragma unroll
    for (int q = 0; q < 8; ++q) { const int idx = tid + 512 * q, row = idx >> 5, c16 = idx & 31; kreg[q] = *(const GAS v4u*)(Kp + (size_t)row * RW + c16 * 8); }
    LAS unsigned char* pl = lds + PL_OFF + wave * PL_WAVE;
    for (int c = 0; c < SEQ / CHK; ++c) {
        const int tok0 = c * CHK;
#pragma unroll
        for (int q = 0; q < 8; ++q) { const int idx = tid + 512 * q, row = idx >> 5, c16 = idx & 31; *(LAS v4u*)(lds + KL_OFF + row * KL_PITCH + c16 * 16) = kreg[q]; }
        __syncthreads();
        if (c + 1 < SEQ / CHK) {
#pragma unroll
            for (int q = 0; q < 8; ++q) { const int idx = tid + 512 * q, row = idx >> 5, c16 = idx & 31; kreg[q] = *(const GAS v4u*)(Kp + (size_t)(tok0 + CHK + row) * RW + c16 * 8); }
        }
        bf16x8 qf[8], vf[4], kt[2][4];
#pragma unroll
        for (int s = 0; s < 8; ++s) qf[s] = *(const GAS bf16x8*)(Qp + (size_t)(tok0 + 16 * rb + i) * RW + 32 * s + 8 * g);
#pragma unroll
        for (int s = 0; s < 4; ++s) vf[s] = *(const GAS bf16x8*)(VTp + (size_t)i * M + tok0 + 32 * s + 8 * g);
#pragma unroll
        for (int t = 0; t < 2; ++t)
#pragma unroll
            for (int s = 0; s < 4; ++s) kt[t][s] = *(const GAS bf16x8*)(KTp + (size_t)(32 * wave + 16 * t + i) * M + tok0 + 32 * s + 8 * g);
        for (int j = 0; j <= rb; ++j) {
            f32x4 acc = (f32x4){0.f, 0.f, 0.f, 0.f};
#pragma unroll
            for (int s = 0; s < 8; ++s) { const bf16x8 a = *(const LAS bf16x8*)(lds + KL_OFF + (16 * j + i) * KL_PITCH + (32 * s + 8 * g) * 2); acc = MFMA16(a, qf[s], acc); }
            if (j == rb) {
#pragma unroll
                for (int r = 0; r < 4; ++r) if (4 * g + r > i) acc[r] = 0.f;
            }
            u32x2 w; w.x = pkbf(acc[0], acc[1]); w.y = pkbf(acc[2], acc[3]);
            *(LAS u32x2*)(pl + i * PL_PITCH + (16 * j + 4 * g) * 2) = w;
        }
        if ((rb & 1) == 0) { u32x2 z; z.x = 0u; z.y = 0u; *(LAS u32x2*)(pl + i * PL_PITCH + (16 * (rb + 1) + 4 * g) * 2) = z; }
        f32x4 o = (f32x4){0.f, 0.f, 0.f, 0.f};
#pragma unroll
        for (int s = 0; s < 4; ++s) if (s <= (rb >> 1)) { const bf16x8 p = *(const LAS bf16x8*)(pl + i * PL_PITCH + (32 * s + 8 * g) * 2); o = MFMA16(vf[s], p, o); }
#pragma unroll
        for (int s = 0; s < 8; ++s) { const bf16x8 rf = *(const LAS bf16x8*)(lds + RL_OFF + i * RL_PITCH + (32 * s + 8 * g) * 2); o = MFMA16(rf, qf[s], o); }
        *(GAS f32x4*)(Rp + (size_t)(tok0 + 16 * rb + i) * RW + 4 * g) = o;
#pragma unroll
        for (int t = 0; t < 2; ++t) { f32x4 tmp = (f32x4){0.f, 0.f, 0.f, 0.f};
#pragma unroll
            for (int s = 0; s < 4; ++s) tmp = MFMA16(vf[s], kt[t][s], tmp);
            st[t] = st[t] * g128 + tmp * g127; }
        __syncthreads();
#pragma unroll
        for (int t = 0; t < 2; ++t)
#pragma unroll
            for (int r = 0; r < 4; ++r) *(LAS bf16*)(lds + RL_OFF + (4 * g + r) * RL_PITCH + (32 * wave + 16 * t + i) * 2) = (bf16)(pkbf(gam * st[t][r], 0.f) & 0xffffu);
    }
    __syncthreads();
}

__device__ __forceinline__ void sg_unit(LAS unsigned char* lds, int tid, int lane, int wave, int ck, int grp, const float* sgw, const float* sgb, const float* lng, const float* lnb,
                                        const float* stats, const bf16* ST, const bf16* UG, bf16* SGU) {
    constexpr int WL_OFF = 0, WL_PITCH = 272, MU_OFF = 128 * WL_PITCH, RS_OFF = MU_OFF + 512, C1_OFF = RS_OFF + 512, C2_OFF = C1_OFF + 512, BS_OFF = C2_OFF + 512;
    const int tok0 = ck * CHK;
    LAS float* MU = (LAS float*)(lds + MU_OFF); LAS float* RS = (LAS float*)(lds + RS_OFF); LAS float* C1 = (LAS float*)(lds + C1_OFF); LAS float* C2 = (LAS float*)(lds + C2_OFF); LAS float* BS = (LAS float*)(lds + BS_OFF);
    if (tid < CHK) {
        const GAS f32x2* sp = (const GAS f32x2*)(stats + (size_t)(tok0 + tid) * 64); float s = 0.f, q = 0.f;
#pragma unroll 8
        for (int p = 0; p < 32; ++p) { const f32x2 v = sp[p]; s += v.x; q += v.y; }
        const float mean = s * (1.f / SGW), var = fmaxf(q * (1.f / SGW) - mean * mean, 0.f);
        MU[tid] = mean; RS[tid] = 1.0f / sqrtf(var + LN_EPS);
    }
    __syncthreads();
    {
        const int t = tid >> 2, sq = tid & 3; const GAS float* wrow = (const GAS float*)sgw + ((size_t)grp * CHK + t) * CHK + 32 * sq;
        float c1 = 0.f, c2 = 0.f;
#pragma unroll
        for (int j = 0; j < 32; j += 2) { const int s = 32 * sq + j; const float w0 = (s <= t) ? wrow[j] : 0.f, w1 = (s + 1 <= t) ? wrow[j + 1] : 0.f;
            const float a0 = w0 * RS[s], a1 = w1 * RS[s + 1]; c2 += w0 + w1; c1 += a0 * MU[s] + a1 * MU[s + 1];
            *(LAS unsigned*)(lds + WL_OFF + t * WL_PITCH + s * 2) = pkbf(a0, a1); }
        c1 += __shfl_xor(c1, 1); c1 += __shfl_xor(c1, 2); c2 += __shfl_xor(c2, 1); c2 += __shfl_xor(c2, 2);
        if (sq == 0) { C1[t] = c1; C2[t] = c2; BS[t] = sgb[grp * CHK + t]; }
    }
    __syncthreads();
    const int i = lane & 15, g = lane >> 4, trow = 16 * wave + i, nsteps = (wave >> 1) + 1;
    bf16x8 wf[4];
#pragma unroll
    for (int s = 0; s < 4; ++s) wf[s] = *(const LAS bf16x8*)(lds + WL_OFF + trow * WL_PITCH + (32 * s + 8 * g) * 2);
    const float c1t = C1[trow], c2t = C2[trow], bst = BS[trow];
    for (int j = 0; j < 16; ++j) {
        f32x4 acc = (f32x4){0.f, 0.f, 0.f, 0.f};
        const GAS bf16* sp = (const GAS bf16*)ST + (size_t)(GD * grp + 16 * j + i) * M + tok0 + 8 * g;
#pragma unroll
        for (int s = 0; s < 4; ++s) if (s < nsteps) { const bf16x8 a = *(const GAS bf16x8*)(sp + 32 * s); acc = MFMA16(a, wf[s], acc); }
        const int ch0 = GD * grp + 16 * j + 4 * g;
        const f32x4 lg = *(const GAS f32x4*)(lng + ch0), lb = *(const GAS f32x4*)(lnb + ch0);
        const u32x2 uw = *(const GAS u32x2*)(UG + (size_t)(tok0 + trow) * SGW + ch0);
        const f32x4 uv = (f32x4){bflo(uw.x), bfhi(uw.x), bflo(uw.y), bfhi(uw.y)};
        const f32x4 val = uv * (lg * (acc - c1t) + lb * c2t + bst);
        u32x2 w; w.x = pkbf(val[0], val[1]); w.y = pkbf(val[2], val[3]);
        *(GAS u32x2*)(SGU + (size_t)(tok0 + trow) * SGW + ch0) = w;
    }
    __syncthreads();
}

__global__ void __launch_bounds__(NWAVES * 64, 2) fwd(Args args) {
    extern __shared__ __attribute__((aligned(16))) unsigned char lds_raw[];
    LAS unsigned char* lds = (LAS unsigned char*)lds_raw;
    volatile LAS unsigned* MISC = (volatile LAS unsigned*)(lds + MISC_OFF);
    const int tid = threadIdx.x, lane = tid & 63, wave = __builtin_amdgcn_readfirstlane(tid >> 6);
    const int G = gridDim.x, bx = blockIdx.x, vcu = (G % 8 == 0) ? (bx % 8) * (G / 8) + bx / 8 : bx;
    const int gw = vcu * NWAVES + wave, NGW = G * NWAVES;
    unsigned char* ws = args.ws;
    unsigned* ctl = (unsigned*)(ws + WS_CTL);
    const float* x = args.in[0]; const float* cin = args.in[1]; const int* pos = (const int*)args.in[2]; const float* w_ada = args.in[3]; const float* b_ada = args.in[4];
    const float* w_in = args.in[5]; const float* sg_ln_g = args.in[6]; const float* sg_ln_b = args.in[7]; const float* sg_w = args.in[8]; const float* sg_b = args.in[9];
    const float* w_ret_up = args.in[10]; const float* w_sg_up = args.in[11]; const float* w_out = args.in[12]; const float* ln1_g = args.in[13]; const float* ln1_b = args.in[14];
    const float* w_gate_up = args.in[15]; const float* w_down = args.in[16]; const float* ln2_g = args.in[17]; const float* ln2_b = args.in[18];
    float* ada = (float*)(ctl + CW_ADA);
    float* cosT = (float*)(ws + WS_COS); float* sinT = (float*)(ws + WS_SIN); float* stats = (float*)(ws + WS_STATS);
    bf16 *WIN = (bf16*)(ws + WS_WIN), *WRET = (bf16*)(ws + WS_WRET), *WSG = (bf16*)(ws + WS_WSG), *WOUT = (bf16*)(ws + WS_WOUT), *WGU = (bf16*)(ws + WS_WGU), *WDN = (bf16*)(ws + WS_WDN);
    bf16 *H = (bf16*)(ws + WS_H), *Qb = (bf16*)(ws + WS_Q), *Kb = (bf16*)(ws + WS_K), *KTb = (bf16*)(ws + WS_KT), *VTb = (bf16*)(ws + WS_VT), *GSb = (bf16*)(ws + WS_GS), *UGb = (bf16*)(ws + WS_UG), *STb = (bf16*)(ws + WS_ST);
    bf16 *SIGR = (bf16*)(ws + WS_SIGR), *SIGS = (bf16*)(ws + WS_SIGS), *RETG = (bf16*)(ws + WS_RETG), *SGU = (bf16*)(ws + WS_SGU), *MIX = (bf16*)(ws + WS_MIX), *ACT = (bf16*)(ws + WS_ACT);
    float *RET = (float*)(ws + WS_RET), *PRE = (float*)(ws + WS_PRE), *X1 = (float*)(ws + WS_X1);

    for (int u = tid; u < (LDS_BYTES - LDSCTL_OFF) / 4; u += NWAVES * 64) ((LAS unsigned*)(lds + LDSCTL_OFF))[u] = 0u;
    __syncthreads();
    XcdBarrier bar; bar.bar = ctl + CW_BAR; bar.x = 0; bar.st = nullptr;
    if (MK_N_LAUNCHES == 1) bar = xcd_barrier_post(ctl + CW_BAR, MISC + 8);
    const int lo = args.ph_lo, hi = args.ph_hi;
#ifndef PH_MASK
#ifdef DBG_STOP
#define PH_MASK (((2u << DBG_STOP) - 1u) | 0x800u)
#else
#define PH_MASK 0xfff
#endif
#endif
#define IN(k) (((PH_MASK >> (k)) & 1) && lo <= (k) && (k) < hi)
#define SEAM(k) do { if (IN(k) && IN((k) + 1)) xcd_barrier(bar); } while (0)

    if (IN(0)) {
        LAS float* scl = (LAS float*)(lds + RING_OFF);
        for (int u = tid; u < BATCH * D; u += NWAVES * 64) { const float v = cin[u]; scl[u] = v / (1.0f + expf(-v)); }
        __syncthreads();
        for (int cb = vcu; cb < ADAW / 96; cb += G) {
            const int half = lane / 24, c4 = lane - 24 * half;
            f32x4 a0 = (f32x4){0.f, 0.f, 0.f, 0.f}, a1 = a0;
            if (lane < 48) {
                const GAS float* wp = (const GAS float*)w_ada + (size_t)(512 * wave + half) * ADAW + cb * 96 + 4 * c4;
#pragma unroll 8
                for (int kk = 0; kk < 256; ++kk) { const f32x4 w = *(const GAS f32x4*)(wp + (size_t)(2 * kk) * ADAW); const int k = 512 * wave + 2 * kk + half; const float s0 = scl[k], s1 = scl[D + k]; a0 += w * s0; a1 += w * s1; }
            }
            LAS f32x4* red = (LAS f32x4*)(lds + RING_OFF + 32768);
            if (lane < 48) { red[(wave * 48 + lane) * 2] = a0; red[(wave * 48 + lane) * 2 + 1] = a1; }
            __syncthreads();
            if (tid < 48) {
                const int bsel = tid / 24, cc = tid - 24 * bsel; f32x4 s = (f32x4){0.f, 0.f, 0.f, 0.f};
#pragma unroll
                for (int w = 0; w < 8; ++w) { s += red[(w * 48 + cc) * 2 + bsel]; s += red[(w * 48 + 24 + cc) * 2 + bsel]; }
                *(GAS f32x4*)(ada + (size_t)bsel * ADAW + cb * 96 + 4 * cc) = s;
            }
            __syncthreads();
        }
        {
            constexpr int I0 = (D / 64) * (INW / 64), I1 = (RW / 64) * (D / 64), I2 = I1, I3 = (D / 64) * (D / 64), I4 = (D / 64) * (2 * DFF / 64), I5 = (DFF / 64) * (D / 64);
            constexpr int NIT = I0 + I1 + I2 + I3 + I4 + I5;
            for (int it = gw; it < NIT; it += NGW) {
                int r = it;
                if (r < I0) { p0_transpose_item(w_in, D, INW, WIN, r % (D / 64), (r / (D / 64)) * 64, (r / (D / 64)) * 64, lane); continue; } r -= I0;
                if (r < I1) { p0_transpose_item(w_ret_up, RW, D, WRET, r % (RW / 64), (r / (RW / 64)) * 64, (r / (RW / 64)) * 64, lane); continue; } r -= I1;
                if (r < I2) { p0_transpose_item(w_sg_up, SGW, D, WSG, r % (SGW / 64), (r / (SGW / 64)) * 64, (r / (SGW / 64)) * 64, lane); continue; } r -= I2;
                if (r < I3) { p0_transpose_item(w_out, D, D, WOUT, r % (D / 64), (r / (D / 64)) * 64, (r / (D / 64)) * 64, lane); continue; } r -= I3;
                if (r < I4) { const int n0 = (r / (D / 64)) * 64; p0_transpose_item(w_gate_up, D, 2 * DFF, WGU, r % (D / 64), n0, gu_row0(n0), lane); continue; } r -= I4;
                p0_transpose_item(w_down, DFF, D, WDN, r % (DFF / 64), (r / (DFF / 64)) * 64, (r / (DFF / 64)) * 64, lane);
            }
        }
        for (int e = (vcu * NWAVES * 64 + tid); e < M * 128; e += G * NWAVES * 64) {
            const int row = e >> 7, j = e & 127;
            const float inv = (float)exp2(-(double)j * (13.287712379549449 / 128.0));
            const float angf = (float)pos[row] * inv;
            const double a = (double)angf; const double rr = a - 6.283185307179586476925 * rint(a * 0.15915494309189533577);
            cosT[e] = cosf((float)rr); sinT[e] = sinf((float)rr);
        }
        __syncthreads();
    }
    SEAM(0);
    if (IN(1)) row_pass<0>(gw, NGW, lane, x, nullptr, nullptr, nullptr, H, ada, b_ada, 0, 1);
    SEAM(1);
    if (IN(2)) {
        pg8::Gemm g{H, WIN, M, INW, D}; pg8::StaticOrder S; S.init(M, INW, G, bx);
        pg8::EpiZ E{ws, stats, cosT, sinT};
        pg8::gemm_phase<pg8::EpiZ, pg8::StaticOrder, true, true>(lds + RING_OFF, g, S, E);
    }
    SEAM(2);
    if (IN(3)) {
        for (int uid = vcu; uid < 256; uid += G) ret_unit(lds + RING_OFF, tid, lane, wave, uid >> 4, uid & 15, Qb, Kb, KTb, VTb, RET);
        for (int uid = vcu; uid < 512; uid += G) sg_unit(lds + RING_OFF, tid, lane, wave, uid >> 3, uid & 7, sg_w, sg_b, sg_ln_g, sg_ln_b, stats, STb, UGb, SGU);
    }
    SEAM(3);
    if (IN(4)) {
        for (int p = gw; p < M * NH; p += NGW) {
            const f32x4 v = *((const GAS f32x4*)(RET + (size_t)p * HD) + lane);
            const float mean = wave_sum((v.x + v.y) + (v.z + v.w)) * (1.f / HD); const f32x4 d = v - mean;
            const float rstd = 1.0f / sqrtf(wave_sum((d.x * d.x + d.y * d.y) + (d.z * d.z + d.w * d.w)) * (1.f / HD) + LN_EPS);
            const u32x2 gwv = *((const GAS u32x2*)(GSb + (size_t)p * HD) + lane);
            const f32x4 o = d * rstd * (f32x4){bflo(gwv.x), bfhi(gwv.x), bflo(gwv.y), bfhi(gwv.y)};
            u32x2 w; w.x = pkbf(o.x, o.y); w.y = pkbf(o.z, o.w); *((GAS u32x2*)(RETG + (size_t)p * HD) + lane) = w;
        }
    }
    SEAM(4);
    if (IN(5)) {
        pg8::Gemm g{RETG, WRET, M, D, RW}; pg8::StaticOrder S; S.init(M, D, G, bx);
        pg8::EpiMix<0> E{SIGR, PRE, nullptr, D};
        pg8::gemm_phase<pg8::EpiMix<0>, pg8::StaticOrder, true, true>(lds + RING_OFF, g, S, E);
    }
    SEAM(5);
    if (IN(6)) {
        pg8::Gemm g{SGU, WSG, M, D, SGW}; pg8::StaticOrder S; S.init(M, D, G, bx);
        pg8::EpiMix<1> E{SIGS, PRE, MIX, D};
        pg8::gemm_phase<pg8::EpiMix<1>, pg8::StaticOrder, true, true>(lds + RING_OFF, g, S, E);
    }
    SEAM(6);
    if (IN(7)) {
        pg8::Gemm g{MIX, WOUT, M, D, D}; pg8::StaticOrder S; S.init(M, D, G, bx);
        pg8::EpiRes E{x, PRE, D, ada + 2 * D, b_ada + 2 * D, ADAW, SEQ, ALPHA};
        pg8::gemm_phase<pg8::EpiRes, pg8::StaticOrder, true, true>(lds + RING_OFF, g, S, E);
    }
    SEAM(7);
    if (IN(8)) row_pass<1>(gw, NGW, lane, PRE, ln1_g, ln1_b, X1, H, ada, b_ada, 3, 4);
    SEAM(8);
    if (IN(9)) {
        pg8::Gemm g{H, WGU, M, 2 * DFF, D}; pg8::StaticOrder S; S.init(M, 2 * DFF, G, bx);
        pg8::EpiSwiGLU E{ACT, DFF};
        pg8::gemm_phase<pg8::EpiSwiGLU, pg8::StaticOrder, true, true>(lds + RING_OFF, g, S, E);
    }
    SEAM(9);
    if (IN(10)) {
        pg8::Gemm g{ACT, WDN, M, D, DFF}; pg8::StaticOrder S; S.init(M, D, G, bx);
        pg8::EpiRes E{X1, PRE, D, ada + 5 * D, b_ada + 5 * D, ADAW, SEQ, ALPHA};
        pg8::gemm_phase<pg8::EpiRes, pg8::StaticOrder, true, true>(lds + RING_OFF, g, S, E);
    }
    SEAM(10);
#ifndef DBG_STOP
    if (IN(11)) row_pass<2>(gw, NGW, lane, PRE, ln2_g, ln2_b, args.out, nullptr, nullptr, nullptr, 0, 0);
#else
    if (IN(11)) {
        const size_t NT = (size_t)G * NWAVES * 64, NE = (size_t)M * D, HN = (size_t)M * 2048;
        for (size_t e = (size_t)vcu * NWAVES * 64 + tid; e < NE; e += NT) {
            float s = 0.f; const size_t eh = e % HN;
            if (DBG_STOP == 1) { s = bflo((unsigned)H[e]) ; }
            if (DBG_STOP == 0) { s = bflo((unsigned)WIN[e]) + bflo((unsigned)WIN[e + NE]) + bflo((unsigned)WGU[e]) + bflo((unsigned)WGU[e + NE]) + bflo((unsigned)WDN[e]) + bflo((unsigned)WOUT[e % ((size_t)D * D)]) + bflo((unsigned)WRET[eh % ((size_t)D * RW)]) + bflo((unsigned)WSG[eh % ((size_t)D * RW)]) + cosT[e % ((size_t)M * 128)] + sinT[e % ((size_t)M * 128)] + ada[e % (2 * ADAW)]; }
            if (DBG_STOP == 2) { s = bflo((unsigned)Qb[eh]) + bflo((unsigned)Kb[eh]) + bflo((unsigned)KTb[eh]) + bflo((unsigned)VTb[eh]) + bflo((unsigned)GSb[eh]) + bflo((unsigned)UGb[eh]) + bflo((unsigned)STb[eh]) + bflo((unsigned)SIGR[e]) + bflo((unsigned)SIGS[e]) + stats[e % ((size_t)M * 64)]; }
#ifndef DBG_P3
#define DBG_P3 3
#endif
            if (DBG_STOP == 3) { s = ((DBG_P3 & 1) ? RET[eh] : 0.f) + ((DBG_P3 & 2) ? bflo((unsigned)SGU[eh]) : 0.f); }
            if (DBG_STOP == 4) { s = bflo((unsigned)RETG[eh]); }
            if (DBG_STOP == 6) { s = bflo((unsigned)MIX[e]); }
            if (DBG_STOP == 7) { s = PRE[e]; }
            if (DBG_STOP == 8) { s = X1[e] + bflo((unsigned)H[e]); }
            if (DBG_STOP == 9) { s = bflo((unsigned)ACT[e]) + bflo((unsigned)ACT[e + NE]); }
            if (DBG_STOP == 10) { s = PRE[e]; }
            args.out[e] = s;
        }
    }
#endif
#undef IN
#undef SEAM
}

extern "C" void kernel_launch(void* const* d_in, const int* in_sizes, int n_in, void* d_out, int out_size, void* d_ws, size_t ws_size, hipStream_t stream) {
    static int grid = 0;
    if (grid == 0) {
        if (n_in != 19 || in_sizes[0] != M * D || out_size != M * D || ws_size < WS_END) { fprintf(stderr, "kernel_launch: unexpected shapes (n_in %d, in0 %d, out %d, ws %zu)\n", n_in, n_in > 0 ? in_sizes[0] : -1, out_size, ws_size); grid = -1; return; }
        int dev = 0, cus = 0, per_cu = 0;
        if (hipGetDevice(&dev) != hipSuccess || hipDeviceGetAttribute(&cus, hipDeviceAttributeMultiprocessorCount, dev) != hipSuccess) { grid = -1; return; }
        if (hipFuncSetAttribute((const void*)fwd, hipFuncAttributeMaxDynamicSharedMemorySize, LDS_BYTES) != hipSuccess) { fprintf(stderr, "kernel_launch: hipFuncSetAttribute failed\n"); grid = -1; return; }
        if (hipOccupancyMaxActiveBlocksPerMultiprocessor(&per_cu, (const void*)fwd, NWAVES * 64, LDS_BYTES) != hipSuccess || per_cu < 1) fprintf(stderr, "kernel_launch: occupancy query reports %d\n", per_cu);
        (void)hipGetLastError();
        grid = cus;
    }
    if (grid < 0) return;
    if (hipMemsetAsync((char*)d_ws + WS_CTL, 0, CTL_ZERO_BYTES, stream) != hipSuccess) { fprintf(stderr, "kernel_launch: memset failed\n"); return; }
    Args a{};
    for (int i = 0; i < 19; ++i) a.in[i] = (const float*)d_in[i];
    a.out = (float*)d_out; a.ws = (unsigned char*)d_ws;
    if (MK_N_LAUNCHES == 1) { a.ph_lo = 0; a.ph_hi = N_PHASES + 1; hipLaunchKernelGGL(fwd, dim3(grid), dim3(NWAVES * 64), LDS_BYTES, stream, a); }
    else for (int p = 0; p <= N_PHASES; ++p) { a.ph_lo = p; a.ph_hi = p + 1; hipLaunchKernelGGL(fwd, dim3(grid), dim3(NWAVES * 64), LDS_BYTES, stream, a); }
    const hipError_t le = hipPeekAtLastError();
    if (le != hipSuccess) fprintf(stderr, "kernel_launch: launch failed: %s\n", hipGetErrorName(le));
}
```

```cpp
#include <hip/hip_runtime.h>
#include <cstdio>
#include <cstdint>
constexpr int NWAVES = 8;
constexpr int BATCH = 2, SEQ = 4096, D = 4096, M = BATCH * SEQ;
constexpr int RW = 2048, NH = 8, HD = 256, SGW = 2048, NG = 8, GD = 256, CHK = 128, DFF = 11008, INW = 20480, ADAW = 6 * D;
constexpr float LN_EPS = 1e-5f;
constexpr float ALPHA = 1.189207115002721f;
#ifndef MK_N_LAUNCHES
#define MK_N_LAUNCHES 1
#endif
constexpr int N_PHASES = 11;

constexpr size_t MiB = 1u << 20;
constexpr size_t WS_CTL = 0, CTL_ZERO_BYTES = 1 * MiB;
constexpr size_t WS_COS = 1 * MiB, WS_SIN = 5 * MiB, WS_STATS = 9 * MiB;
constexpr size_t WS_WIN = 16 * MiB, WS_WRET = 176 * MiB, WS_WSG = 192 * MiB, WS_WOUT = 208 * MiB, WS_WGU = 240 * MiB, WS_WDN = 412 * MiB;
constexpr size_t WS_H = 498 * MiB, WS_Q = 562 * MiB, WS_K = 594 * MiB, WS_KT = 626 * MiB, WS_VT = 658 * MiB, WS_GS = 690 * MiB, WS_UG = 722 * MiB, WS_ST = 754 * MiB;
constexpr size_t WS_SIGR = 786 * MiB, WS_SIGS = 850 * MiB, WS_RET = 914 * MiB, WS_RETG = 978 * MiB, WS_SGU = 1010 * MiB, WS_MIX = 1042 * MiB, WS_PRE = 1106 * MiB, WS_X1 = 1234 * MiB;
constexpr size_t WS_ACT = 562 * MiB;
constexpr size_t WS_END = 1362 * MiB;
static_assert(WS_WGU + (size_t)2 * DFF * D * 2 <= WS_WDN && WS_WDN + (size_t)D * DFF * 2 <= WS_H && WS_ACT + (size_t)M * DFF * 2 <= WS_ST, "d_ws map");
constexpr int CW_BAR = 4096;
constexpr int CW_ADA = 65536;
static_assert((CW_ADA + 2 * ADAW) * 4 <= (int)CTL_ZERO_BYTES, "ctl");

constexpr int RING_OFF = 0, RING_BYTES = 131072;
constexpr int LDSCTL_OFF = RING_BYTES, MISC_OFF = LDSCTL_OFF + 320;
constexpr int LDS_BYTES = 147456;

namespace pg8 {
#define PG8_LAS __attribute__((address_space(3)))
typedef unsigned short bf16_t;
typedef short bf16x8 __attribute__((ext_vector_type(8)));
typedef float f32x4 __attribute__((ext_vector_type(4)));
typedef unsigned u32x4 __attribute__((ext_vector_type(4)));
constexpr int BM = 256, BK = 64, HALF = 128, HTB = HALF * BK * 2  , STAGE_BYTES = 8 * HTB, NXCD = 8, WGM = 8;

__host__ __device__ __forceinline__ int lds_byte(int r, int c) { const int st = (r >> 4) * 2 + (c >> 5), rr = r & 15, cc = c & 31, ob = rr * 64 + cc * 2; return st * 1024 + (ob ^ (((ob >> 9) & 1) << 5)); }
__host__ __device__ __forceinline__ void stage_rc(int b, int& R, int& C) { const int st = b / 1024, sb = b % 1024, swz = sb ^ (((sb >> 9) & 1) << 5); R = (st >> 1) * 16 + swz / 64; C = (st & 1) * 32 + (swz % 64) / 2; }
__host__ __device__ __forceinline__ int perm32(int rho) { const int n = rho >> 4, i = rho & 15; return 8 * (i >> 2) + 4 * n + (i & 3); }

struct Unit { int pm, pn; };
struct Gemm { const bf16_t* A; const bf16_t* Bt; int M, N, K; };

struct StaticOrder {
    int nM, nN, nwg, G, c; unsigned long long* prb = nullptr;
    __host__ __device__ void init(int M, int N, int G_, int c_) { nM = M / BM; nN = N / BM; nwg = nM * nN; G = G_; c = c_; }
    __host__ __device__ bool next(int i, Unit& u) const {
        const long L = (long)i * G + c; if (L >= nwg) return false;
        int wgid = (int)L; { const int q = nwg / NXCD, r = nwg % NXCD, xcd = wgid % NXCD, off = wgid / NXCD; wgid = (xcd < r ? xcd * (q + 1) : r * (q + 1) + (xcd - r) * q) + off; }
        const int nig = WGM * nN, gid = wgid / nig, fm = gid * WGM, gsz = (nM - fm) < WGM ? (nM - fm) : WGM;
        u.pm = fm + ((wgid % nig) % gsz); u.pn = (wgid % nig) / gsz; return true;
    }
    __device__ __forceinline__ void a_ready(const Unit&) const {}
    __device__ __forceinline__ void done(const Unit&) const {}
};
typedef __bf16 bf16v2_t __attribute__((ext_vector_type(2)));
typedef float f32v2_t __attribute__((ext_vector_type(2)));
__device__ __forceinline__ unsigned cvt_pk_bf16(float lo, float hi) { const f32v2_t v = {lo, hi}; const bf16v2_t b = __builtin_convertvector(v, bf16v2_t); return __builtin_bit_cast(unsigned, b); }
typedef float f32x2 __attribute__((ext_vector_type(2)));
typedef unsigned u32x2 __attribute__((ext_vector_type(2)));
__device__ __forceinline__ float fast_sigmoid(float x) { return __builtin_amdgcn_rcpf(1.0f + __builtin_amdgcn_exp2f(-1.4426950408889634f * x)); }
__device__ __forceinline__ float fast_silu(float x) { return x * fast_sigmoid(x); }
__device__ __forceinline__ float gelu_tanh(float x) { const float y = 1.5957691216057308f * (x + 0.044715f * x * x * x); return x * fast_sigmoid(y); }
__device__ __forceinline__ float bf_lo(unsigned w) { return __uint_as_float(w << 16); }
__device__ __forceinline__ float bf_hi(unsigned w) { return __uint_as_float(w & 0xffff0000u); }

__device__ __forceinline__ float log2_gamma(int h) { const float xg = __builtin_amdgcn_exp2f(-5.0f - (float)h); const float x2 = xg * xg; return -1.4426950408889634f * (xg + x2 * 0.5f + x2 * xg * (1.0f / 3.0f) + x2 * x2 * 0.25f + x2 * x2 * xg * 0.2f); }
struct EpiZ {
    static constexpr bool PERM = true, AFTER_DRAIN = false;
    unsigned char* ws; float* stats; const float *cosT, *sinT;
    __device__ __forceinline__ void operator()(const f32x4 (&acc)[2][2][4][2], const Unit& u, int wr, int wc, int fr, int fq) const {
        const int pn = u.pn, row0 = u.pm * BM + wr * 64 + fr, cl = wc * 32 + 8 * fq;
        if (pn < 16) {
            const int h = pn & 7; const bool isk = pn >= 8;
            const float l2g = log2_gamma(h);
            bf16_t* dst = (bf16_t*)(ws + (isk ? WS_K : WS_Q));
#pragma unroll
            for (int ai = 0; ai < 2; ++ai)
#pragma unroll
                for (int m = 0; m < 4; ++m) {
                    const int r = row0 + ai * HALF + m * 16, nloc = r & 127;
                    const float sc = isk ? 0.0625f * __builtin_amdgcn_exp2f(-(float)nloc * l2g) : __builtin_amdgcn_exp2f((float)nloc * l2g);
                    const float* cp = cosT + (size_t)r * 128 + cl; const float* sp = sinT + (size_t)r * 128 + cl;
                    const f32x4 c0 = *(const f32x4*)cp, c1 = *(const f32x4*)(cp + 4), s0 = *(const f32x4*)sp, s1 = *(const f32x4*)(sp + 4);
                    const f32x4 xa = acc[ai][0][m][0], xb = acc[ai][0][m][1], ya = acc[ai][1][m][0], yb = acc[ai][1][m][1];
                    const f32x4 o1a = (xa * c0 - ya * s0) * sc, o1b = (xb * c1 - yb * s1) * sc, o2a = (ya * c0 + xa * s0) * sc, o2b = (yb * c1 + xb * s1) * sc;
                    u32x4 w1, w2; w1.x = cvt_pk_bf16(o1a[0], o1a[1]); w1.y = cvt_pk_bf16(o1a[2], o1a[3]); w1.z = cvt_pk_bf16(o1b[0], o1b[1]); w1.w = cvt_pk_bf16(o1b[2], o1b[3]);
                    w2.x = cvt_pk_bf16(o2a[0], o2a[1]); w2.y = cvt_pk_bf16(o2a[2], o2a[3]); w2.z = cvt_pk_bf16(o2b[0], o2b[1]); w2.w = cvt_pk_bf16(o2b[2], o2b[3]);
                    bf16_t* rowp = dst + (size_t)r * 2048 + 256 * h + cl;
                    *(u32x4*)rowp = w1; *(u32x4*)(rowp + 128) = w2;
                    if (isk) {
                        bf16_t* t1 = (bf16_t*)(ws + WS_KT) + ((size_t)((((r >> 12) * 8 + h) * 32 + ((r >> 7) & 31)) * 256 + cl)) * 128 + (r & 127); bf16_t* t2 = t1 + 128 * 128;
#pragma unroll
                        for (int q = 0; q < 4; ++q) { const unsigned a = w1[q], b = w2[q];
                            t1[(2 * q) * 128] = (bf16_t)(a & 0xffffu); t1[(2 * q + 1) * 128] = (bf16_t)(a >> 16);
                            t2[(2 * q) * 128] = (bf16_t)(b & 0xffffu); t2[(2 * q + 1) * 128] = (bf16_t)(b >> 16); }
                    }
                    asm volatile("" ::: "memory");
                }
        } else if (pn < 24 || (pn >= 40 && pn < 48)) {
            const bool iss = pn >= 40; bf16_t* T = (bf16_t*)(ws + (iss ? WS_ST : WS_VT)); const int ct = (iss ? pn - 40 : pn - 16) * 256;
#pragma unroll
            for (int ai = 0; ai < 2; ++ai)
#pragma unroll
                for (int m = 0; m < 4; ++m) {
                    const int r = row0 + ai * HALF + m * 16; float sum = 0.f, sq = 0.f;
#pragma unroll
                    for (int bj = 0; bj < 2; ++bj)
#pragma unroll
                        for (int n = 0; n < 2; ++n) {
                            f32x4 v = acc[ai][bj][m][n];
                            if (iss) { v[0] = gelu_tanh(v[0]); v[1] = gelu_tanh(v[1]); v[2] = gelu_tanh(v[2]); v[3] = gelu_tanh(v[3]); }
                            const unsigned a = cvt_pk_bf16(v[0], v[1]), b = cvt_pk_bf16(v[2], v[3]);
                            if (iss) { const float f0 = bf_lo(a), f1 = bf_hi(a), f2 = bf_lo(b), f3 = bf_hi(b); sum += (f0 + f1) + (f2 + f3); sq += (f0 * f0 + f1 * f1) + (f2 * f2 + f3 * f3); }
                            const int cc = ct + bj * HALF + cl + 4 * n;
                            bf16_t* t = T + (iss ? ((size_t)(r >> 7) * 2048 + cc) * 128 : ((size_t)((((r >> 12) * 8 + (ct >> 8)) * 32 + ((r >> 7) & 31)) * 256) + (cc & 255)) * 128) + (r & 127);
                            t[0] = (bf16_t)(a & 0xffffu); t[128] = (bf16_t)(a >> 16); t[256] = (bf16_t)(b & 0xffffu); t[384] = (bf16_t)(b >> 16);
                        }
                    if (iss) {
                        sum += __shfl_xor(sum, 16); sum += __shfl_xor(sum, 32); sq += __shfl_xor(sq, 16); sq += __shfl_xor(sq, 32);
                        if (fq == 0) { f32x2 o; o.x = sum; o.y = sq; *(f32x2*)(stats + (size_t)r * 64 + ((pn - 40) * 4 + wc) * 2) = o; }
                    }
                    asm volatile("" ::: "memory");
                }
        } else {
            const int kind = pn < 32 ? 0 : (pn < 40 ? 1 : 2);
            size_t doff; int ldc, ct;
            if (pn < 32) { doff = WS_GS; ldc = 2048; ct = (pn - 24) * 256; } else if (pn < 40) { doff = WS_UG; ldc = 2048; ct = (pn - 32) * 256; }
            else if (pn < 64) { doff = WS_SIGR; ldc = 4096; ct = (pn - 48) * 256; } else { doff = WS_SIGS; ldc = 4096; ct = (pn - 64) * 256; }
            bf16_t* dst = (bf16_t*)(ws + doff);
#pragma unroll
            for (int ai = 0; ai < 2; ++ai)
#pragma unroll
                for (int m = 0; m < 4; ++m) {
                    const int r = row0 + ai * HALF + m * 16; bf16_t* rowp = dst + (size_t)r * ldc + ct + cl;
#pragma unroll
                    for (int bj = 0; bj < 2; ++bj) {
                        f32x4 v0 = acc[ai][bj][m][0], v1 = acc[ai][bj][m][1];
#pragma unroll
                        for (int j = 0; j < 4; ++j) {
                            if (kind == 0) { v0[j] = fast_silu(v0[j]); v1[j] = fast_silu(v1[j]); }
                            else if (kind == 1) { v0[j] = gelu_tanh(v0[j]); v1[j] = gelu_tanh(v1[j]); }
                            else { v0[j] = fast_sigmoid(v0[j]); v1[j] = fast_sigmoid(v1[j]); } }
                        u32x4 w; w.x = cvt_pk_bf16(v0[0], v0[1]); w.y = cvt_pk_bf16(v0[2], v0[3]); w.z = cvt_pk_bf16(v1[0], v1[1]); w.w = cvt_pk_bf16(v1[2], v1[3]);
                        *(u32x4*)(rowp + bj * HALF) = w; }
                }
        }
    }
};

struct EpiSwiGLU {
    static constexpr bool PERM = true, AFTER_DRAIN = false;
    bf16_t* O; int ldc;
    __device__ __forceinline__ void operator()(const f32x4 (&acc)[2][2][4][2], const Unit& u, int wr, int wc, int fr, int fq) const {
        const int row0 = u.pm * BM + wr * 64 + fr, col0 = u.pn * HALF + wc * 32 + 8 * fq;
#pragma unroll
        for (int ai = 0; ai < 2; ++ai)
#pragma unroll
            for (int m = 0; m < 4; ++m) {
                const f32x4 g0 = acc[ai][0][m][0], g1 = acc[ai][0][m][1], u0 = acc[ai][1][m][0], u1 = acc[ai][1][m][1]; f32x4 v0, v1;
#pragma unroll
                for (int j = 0; j < 4; ++j) { v0[j] = fast_silu(g0[j]) * u0[j]; v1[j] = fast_silu(g1[j]) * u1[j]; }
                u32x4 w; w.x = cvt_pk_bf16(v0[0], v0[1]); w.y = cvt_pk_bf16(v0[2], v0[3]); w.z = cvt_pk_bf16(v1[0], v1[1]); w.w = cvt_pk_bf16(v1[2], v1[3]);
                *(u32x4*)(O + (size_t)(row0 + ai * HALF + m * 16) * ldc + col0) = w; }
    }
};

template <int MODE> struct EpiMix {
    static constexpr bool PERM = false, AFTER_DRAIN = false;
    const bf16_t* gate; float* T; bf16_t* O; int ldc;
    __device__ __forceinline__ void operator()(const f32x4 (&acc)[2][2][4][2], const Unit& u, int wr, int wc, int fr, int fq) const {
        const int row0 = u.pm * BM + wr * 64 + fr, col0 = u.pn * BM + wc * 32 + 4 * fq;
#pragma unroll
        for (int ai = 0; ai < 2; ++ai)
#pragma unroll
            for (int m = 0; m < 4; ++m) { const size_t off = (size_t)(row0 + ai * HALF + m * 16) * ldc + col0;
#pragma unroll
                for (int bj = 0; bj < 2; ++bj)
#pragma unroll
                    for (int n = 0; n < 2; ++n) { const size_t o = off + bj * HALF + n * 16;
                        const u32x2 gw = *(const u32x2*)(gate + o); const f32x4 gv = (f32x4){bf_lo(gw.x), bf_hi(gw.x), bf_lo(gw.y), bf_hi(gw.y)};
                        if (MODE == 0) { *(f32x4*)(T + o) = gv * acc[ai][bj][m][n]; }
                        else { const f32x4 v = *(const f32x4*)(T + o) + gv * acc[ai][bj][m][n]; u32x2 w; w.x = cvt_pk_bf16(v[0], v[1]); w.y = cvt_pk_bf16(v[2], v[3]); *(u32x2*)(O + o) = w; } } }
    }
};

template <bool RES_BF16> struct EpiRes {
    static constexpr bool PERM = true, AFTER_DRAIN = false;
    const void* res; bf16_t* P; int ldc; const float* ga; const float* gb; int ga_stride; int rows_per_batch; float alpha;
    __device__ __forceinline__ void operator()(const f32x4 (&acc)[2][2][4][2], const Unit& u, int wr, int wc, int fr, int fq) const {
        const int row0 = u.pm * BM + wr * 64 + fr, col0 = u.pn * BM + wc * 32 + 8 * fq; const int b = (u.pm * BM) / rows_per_batch;
        f32x4 gv[2][2];
#pragma unroll
        for (int bj = 0; bj < 2; ++bj)
#pragma unroll
            for (int n = 0; n < 2; ++n) gv[bj][n] = *(const f32x4*)(ga + (size_t)b * ga_stride + col0 + bj * HALF + n * 4) + *(const f32x4*)(gb + col0 + bj * HALF + n * 4) + 1.0f;
#pragma unroll
        for (int ai = 0; ai < 2; ++ai)
#pragma unroll
            for (int m = 0; m < 4; ++m) { const size_t off = (size_t)(row0 + ai * HALF + m * 16) * ldc + col0;
#pragma unroll
                for (int bj = 0; bj < 2; ++bj) { const size_t o = off + bj * HALF;
                    f32x4 r0, r1;
                    if (RES_BF16) { const u32x4 rw = *(const u32x4*)((const bf16_t*)res + o); r0 = (f32x4){bf_lo(rw.x), bf_hi(rw.x), bf_lo(rw.y), bf_hi(rw.y)}; r1 = (f32x4){bf_lo(rw.z), bf_hi(rw.z), bf_lo(rw.w), bf_hi(rw.w)}; }
                    else { r0 = *(const f32x4*)((const float*)res + o); r1 = *(const f32x4*)((const float*)res + o + 4); }
                    const f32x4 v0 = r0 * alpha + gv[bj][0] * acc[ai][bj][m][0], v1 = r1 * alpha + gv[bj][1] * acc[ai][bj][m][1];
                    u32x4 w; w.x = cvt_pk_bf16(v0[0], v0[1]); w.y = cvt_pk_bf16(v0[2], v0[3]); w.z = cvt_pk_bf16(v1[0], v1[1]); w.w = cvt_pk_bf16(v1[2], v1[3]);
                    *(u32x4*)(P + o) = w; } }
    }
};

struct EpiNull {
    static constexpr bool PERM = true, AFTER_DRAIN = false;
    float* sink;
    __device__ __forceinline__ void operator()(const f32x4 (&acc)[2][2][4][2], const Unit& u, int wr, int wc, int fr, int fq) const {
        float s = 0.f;
#pragma unroll
        for (int ai = 0; ai < 2; ++ai)
#pragma unroll
            for (int bj = 0; bj < 2; ++bj)
#pragma unroll
                for (int m = 0; m < 4; ++m)
#pragma unroll
                    for (int n = 0; n < 2; ++n) s += (acc[ai][bj][m][n][0] + acc[ai][bj][m][n][1]) + (acc[ai][bj][m][n][2] + acc[ai][bj][m][n][3]);
        if (s == 123456.789f) sink[0] = s;
    }
};
template <class Epi, class Sched, bool ALIGN_EPI = false, bool SP2 = false>
__device__ __forceinline__ void gemm_phase(PG8_LAS unsigned char* lds, const Gemm g, const Sched& S, const Epi& E) {
    int tid = threadIdx.x; asm volatile("" : "+v"(tid));
    const int wid = __builtin_amdgcn_readfirstlane(tid >> 6), lane = tid & 63, wr = wid >> 2, wc = wid & 3, fr = lane & 15, fq = lane >> 4;
    const int K = g.K, nt = K / BK;
    unsigned voffA[2], voffB[2];
#pragma unroll
    for (int i = 0; i < 2; ++i) { int R, C; stage_rc(tid * 16 + i * 8192, R, C); const int Rb = Epi::PERM ? ((R & ~31) + perm32(R & 31)) : R;
        voffA[i] = (unsigned)(R * K + C) * 2u; voffB[i] = (unsigned)(Rb * K + C) * 2u; }
    const size_t kstep = (size_t)(BK * 2);
    const size_t hstep = (size_t)HALF * K * 2;
    const size_t tstep = 2 * hstep;
    const unsigned ldsw = (unsigned)wid * 1024u;
    const int aoff = lds_byte(wr * 64 + fr, fq * 8), boff = lds_byte(wc * 32 + fr, fq * 8);
#define PG8_SA(b, h) (((b) * 2 + (h)) * HTB)
#define PG8_SB(b, h) ((4 + (b) * 2 + (h)) * HTB)
#define PG8_STAGE(bufoff, gbase, voff) do { _Pragma("unroll") for (int _i = 0; _i < 2; ++_i) \
        __builtin_amdgcn_global_load_lds((const unsigned*)((const char*)(gbase) + (voff)[_i]), (PG8_LAS unsigned*)(lds + (bufoff) + ldsw + _i * 8192), 16, 0, 0); } while (0)
#define PG8_LDA(dst, b, h) do { _Pragma("unroll") for (int m = 0; m < 4; ++m) _Pragma("unroll") for (int k = 0; k < 2; ++k) dst[m][k] = *(const PG8_LAS bf16x8*)(lds + PG8_SA(b, h) + aoff + m * 2048 + k * 1024); } while (0)
#define PG8_LDB(dst, b, h) do { _Pragma("unroll") for (int n = 0; n < 2; ++n) _Pragma("unroll") for (int k = 0; k < 2; ++k) dst[n][k] = *(const PG8_LAS bf16x8*)(lds + PG8_SB(b, h) + boff + n * 2048 + k * 1024); } while (0)
#define PG8_MMA(ai, bj, At, Bt) do { __builtin_amdgcn_s_setprio(1); _Pragma("unroll") for (int m = 0; m < 4; ++m) _Pragma("unroll") for (int n = 0; n < 2; ++n) _Pragma("unroll") for (int k = 0; k < 2; ++k) \
        acc[ai][bj][m][n] = __builtin_amdgcn_mfma_f32_16x16x32_bf16(Bt[n][k], At[m][k], acc[ai][bj][m][n], 0, 0, 0); __builtin_amdgcn_s_setprio(0); } while (0)
#define PG8_WAIT_V(n) asm volatile("s_waitcnt vmcnt(" #n ")" ::: "memory")
#define PG8_WAIT_L(n) asm volatile("s_waitcnt lgkmcnt(" #n ")" ::: "memory")
#define PG8_BAR __builtin_amdgcn_s_barrier()
#define PG8_SCHED __builtin_amdgcn_sched_barrier(0)
    Unit cur, nxt; int ui = 0;
    if (!S.next(0, cur)) return;
    f32x4 acc[2][2][4][2];
#pragma unroll
    for (int a = 0; a < 2; ++a)
#pragma unroll
        for (int b = 0; b < 2; ++b)
#pragma unroll
            for (int m = 0; m < 4; ++m)
#pragma unroll
                for (int n = 0; n < 2; ++n) acc[a][b][m][n] = (f32x4){0.f, 0.f, 0.f, 0.f};
    bf16x8 At[4][2], B0[2][2], B1[2][2];
    const char* cA = (const char*)g.A + (size_t)cur.pm * tstep; const char* cB = (const char*)g.Bt + (size_t)cur.pn * tstep;
    S.a_ready(cur);
    if constexpr (SP2) {
        PG8_STAGE(PG8_SB(0, 0), cB, voffB); PG8_STAGE(PG8_SB(0, 1), cB + hstep, voffB); PG8_STAGE(PG8_SA(0, 0), cA, voffA); PG8_STAGE(PG8_SA(0, 1), cA + hstep, voffA);
        if (wr == 1) PG8_BAR;
        PG8_WAIT_V(2); PG8_BAR;
        PG8_STAGE(PG8_SB(1, 0), cB + kstep, voffB); PG8_STAGE(PG8_SA(1, 0), cA + kstep, voffA); PG8_STAGE(PG8_SB(1, 1), cB + hstep + kstep, voffB);
        PG8_WAIT_V(6); PG8_BAR;
    } else {
        PG8_STAGE(PG8_SB(0, 0), cB, voffB); PG8_STAGE(PG8_SA(0, 0), cA, voffA); PG8_STAGE(PG8_SB(0, 1), cB + hstep, voffB); PG8_STAGE(PG8_SA(0, 1), cA + hstep, voffA);
        if (wr == 1) PG8_BAR;
        PG8_WAIT_V(4); PG8_BAR;
        PG8_STAGE(PG8_SB(1, 0), cB + kstep, voffB); PG8_STAGE(PG8_SA(1, 0), cA + kstep, voffA); PG8_STAGE(PG8_SB(1, 1), cB + hstep + kstep, voffB);
        PG8_WAIT_V(6); PG8_BAR;
    }
#ifdef GP_STAMP
    unsigned long long gp_tk = 0, gp_te = 0, gp_tf = 0, gp_ts = __builtin_amdgcn_s_memrealtime(), gp_tm = 0;
#endif
    for (;;) {
        const bool has_next = S.next(ui + 1, nxt);
        const char* nA = has_next ? (const char*)g.A + (size_t)nxt.pm * tstep : cA; const char* nB = has_next ? (const char*)g.Bt + (size_t)nxt.pn * tstep : cB;
        for (int t = 0; t < nt; t += 2) {
#ifdef GP_STAMP
            if (t == 4) gp_tf += __builtin_amdgcn_s_memrealtime() - gp_ts;
#endif
            const bool last = (t == nt - 2);
            const char* a1 = cA + (size_t)(t + 1) * kstep;
            const char* a2 = last ? nA : cA + (size_t)(t + 2) * kstep; const char* b2 = last ? nB : cB + (size_t)(t + 2) * kstep;
            const char* a3 = a2 + kstep; const char* b3 = b2 + kstep;
            if (last && has_next) S.a_ready(nxt);
            if constexpr (SP2) {
            PG8_LDB(B0, 0, 0); PG8_LDB(B1, 0, 1); PG8_SCHED; PG8_LDA(At, 0, 0); PG8_STAGE(PG8_SA(1, 1), a1 + hstep, voffA);
            PG8_WAIT_V(8); PG8_WAIT_L(0); PG8_BAR; PG8_MMA(0, 0, At, B0); PG8_MMA(0, 1, At, B1); PG8_BAR; PG8_SCHED;
            PG8_LDA(At, 0, 1); PG8_STAGE(PG8_SB(0, 0), b2, voffB); PG8_STAGE(PG8_SB(0, 1), b2 + hstep, voffB); PG8_STAGE(PG8_SA(0, 0), a2, voffA);
            PG8_WAIT_V(8); PG8_WAIT_L(0); PG8_BAR; PG8_MMA(1, 0, At, B0); PG8_MMA(1, 1, At, B1); PG8_BAR; PG8_SCHED;
            PG8_LDB(B0, 1, 0); PG8_LDB(B1, 1, 1); PG8_SCHED; PG8_LDA(At, 1, 0); PG8_STAGE(PG8_SA(0, 1), a2 + hstep, voffA);
            PG8_WAIT_V(8); PG8_WAIT_L(0); PG8_BAR; PG8_MMA(0, 0, At, B0); PG8_MMA(0, 1, At, B1); PG8_BAR; PG8_SCHED;
            PG8_LDA(At, 1, 1); PG8_STAGE(PG8_SB(1, 0), b3, voffB); PG8_STAGE(PG8_SB(1, 1), b3 + hstep, voffB); PG8_STAGE(PG8_SA(1, 0), a3, voffA);
            PG8_WAIT_V(8); PG8_WAIT_L(0); PG8_BAR; PG8_MMA(1, 0, At, B0); PG8_MMA(1, 1, At, B1); PG8_BAR; PG8_SCHED;
            } else {
            PG8_LDB(B0, 0, 0); PG8_SCHED; PG8_LDA(At, 0, 0); PG8_STAGE(PG8_SA(1, 1), a1 + hstep, voffA);
            PG8_WAIT_L(8); PG8_BAR; PG8_WAIT_L(0); PG8_MMA(0, 0, At, B0); PG8_BAR; PG8_SCHED;
            PG8_LDB(B1, 0, 1); PG8_STAGE(PG8_SB(0, 0), b2, voffB);
            PG8_BAR; PG8_WAIT_L(0); PG8_MMA(0, 1, At, B1); PG8_BAR;
            PG8_LDA(At, 0, 1); PG8_STAGE(PG8_SA(0, 0), a2, voffA);
            PG8_BAR; PG8_WAIT_L(0); PG8_MMA(1, 0, At, B0); PG8_BAR; PG8_SCHED;
            PG8_STAGE(PG8_SB(0, 1), b2 + hstep, voffB);
            PG8_WAIT_V(6); PG8_BAR; PG8_MMA(1, 1, At, B1); PG8_BAR;
            PG8_LDB(B0, 1, 0); PG8_SCHED; PG8_LDA(At, 1, 0); PG8_STAGE(PG8_SA(0, 1), a2 + hstep, voffA);
            PG8_WAIT_L(8); PG8_BAR; PG8_WAIT_L(0); PG8_MMA(0, 0, At, B0); PG8_BAR; PG8_SCHED;
            PG8_LDB(B1, 1, 1); PG8_STAGE(PG8_SB(1, 0), b3, voffB);
            PG8_BAR; PG8_WAIT_L(0); PG8_MMA(0, 1, At, B1); PG8_BAR;
            PG8_LDA(At, 1, 1); PG8_STAGE(PG8_SA(1, 0), a3, voffA);
            PG8_BAR; PG8_WAIT_L(0); PG8_MMA(1, 0, At, B0); PG8_BAR; PG8_SCHED;
            PG8_STAGE(PG8_SB(1, 1), b3 + hstep, voffB);
            PG8_WAIT_V(6); PG8_BAR; PG8_MMA(1, 1, At, B1); PG8_BAR;
            }
        }
#ifdef GP_STAMP
        gp_tm = __builtin_amdgcn_s_memrealtime(); gp_tk += gp_tm - gp_ts;
#endif
        if constexpr (ALIGN_EPI) { if (wr == 0) PG8_BAR; }
        if constexpr (!Epi::AFTER_DRAIN) { E(acc, cur, wr, wc, fr, fq); S.done(cur); }
        if (!has_next) break;
#pragma unroll
        for (int a = 0; a < 2; ++a)
#pragma unroll
            for (int b = 0; b < 2; ++b)
#pragma unroll
                for (int m = 0; m < 4; ++m)
#pragma unroll
                    for (int n = 0; n < 2; ++n) acc[a][b][m][n] = (f32x4){0.f, 0.f, 0.f, 0.f};
        cur = nxt; cA = nA; cB = nB; ++ui;
        if constexpr (ALIGN_EPI) { if (wr == 1) PG8_BAR; }
#ifdef GP_STAMP
        gp_ts = __builtin_amdgcn_s_memrealtime(); gp_te += gp_ts - gp_tm;
#endif
    }
#ifdef GP_STAMP
    if (S.prb && blockIdx.x == 0 && threadIdx.x == 0) { S.prb[0] += gp_tk; S.prb[1] += gp_te + (__builtin_amdgcn_s_memrealtime() - gp_tm); S.prb[2] += gp_tf; }
#endif
    PG8_WAIT_V(0);
    if constexpr (!ALIGN_EPI) { if (wr == 0) PG8_BAR; }
    PG8_BAR;
    if constexpr (Epi::AFTER_DRAIN) { E.fused(acc, cur, wr, wc, fr, fq, lds, wid, lane); S.done(cur); }
#undef PG8_SA
#undef PG8_SB
#undef PG8_STAGE
#undef PG8_LDA
#undef PG8_LDB
#undef PG8_MMA
#undef PG8_WAIT_V
#undef PG8_WAIT_L
#undef PG8_BAR
#undef PG8_SCHED
}
}
#define GAS __attribute__((address_space(1)))
#define LAS __attribute__((address_space(3)))
typedef unsigned short bf16;
typedef unsigned v4u __attribute__((ext_vector_type(4)));
typedef float f32x4 __attribute__((ext_vector_type(4)));
typedef short bf16x8 __attribute__((ext_vector_type(8)));
typedef GAS unsigned gu32;
typedef GAS unsigned long long gu64;
#define RLX_AGENT __ATOMIC_RELAXED, __HIP_MEMORY_SCOPE_AGENT
#define LDS_WAIT() asm volatile("s_waitcnt lgkmcnt(0)" ::: "memory")
#define VM_WAIT() asm volatile("s_waitcnt vmcnt(0)" ::: "memory")
__device__ __forceinline__ unsigned long long rt() { return __builtin_amdgcn_s_memrealtime(); }
__device__ __forceinline__ unsigned f2bf(float f) { unsigned u = __builtin_bit_cast(unsigned, f); return (u + 0x7fffu + ((u >> 16) & 1u)) >> 16; }
__device__ __forceinline__ unsigned pk2(float lo, float hi) { return f2bf(lo) | (f2bf(hi) << 16); }
#define XB_TMO      128
#define XB_XCNT(j)  (256  + 64 * (j))
#define XB_XSUB(j)  (1280 + 64 * (j))
#define XB_XGEN(j)  (2304 + 64 * (j))
#define XB_TOP      3328
#define XB_TOPGEN   3392
#define XCD_BAR_WORDS 3456
#define XB_SPIN_CAP (1u << 18)

__device__ __forceinline__ unsigned xb_ld(unsigned* p)              { return __hip_atomic_load(p, __ATOMIC_RELAXED, __HIP_MEMORY_SCOPE_AGENT); }
__device__ __forceinline__ unsigned xb_add(unsigned* p, unsigned v) { return __hip_atomic_fetch_add(p, v, __ATOMIC_RELAXED, __HIP_MEMORY_SCOPE_AGENT); }
__device__ __forceinline__ unsigned xb_xcc_id() { return (unsigned)__builtin_amdgcn_s_getreg((3 << 11) | 20) & 0xFu; }
#define XB_SPIN(cond, bar) do { unsigned _sp = 0; while (cond) { __builtin_amdgcn_s_sleep(1); \
    if ((++_sp & 255u) == 0u) { if (xb_ld(&(bar)[XB_TMO])) break; if (_sp > XB_SPIN_CAP) { atomicAdd(&(bar)[XB_TMO], 1u); break; } } } } while (0)

struct XcdBarrier {
    unsigned* bar; unsigned x;
    volatile LAS unsigned* st;
};

__device__ __forceinline__ XcdBarrier xcd_barrier_post(unsigned* bar, volatile LAS unsigned* st) {
    XcdBarrier b; b.bar = bar; b.x = xb_xcc_id(); b.st = st;
    if (threadIdx.x == 0) (void)xb_add(&bar[XB_XCNT(b.x)], 1u);
    return b;
}
__device__ __forceinline__ void xcd_barrier_complete(unsigned* bar, unsigned x, unsigned& nloc, unsigned& nx) {
    const unsigned G = gridDim.x * gridDim.y * gridDim.z;
    unsigned sum, cnt, mine, sp = 0u;
    for (;;) {
        sum = 0u; cnt = 0u; mine = 0u;
#pragma unroll
        for (unsigned j = 0; j < 16; ++j) { const unsigned c = xb_ld(&bar[XB_XCNT(j)]); sum += c; cnt += (c > 0u) ? 1u : 0u; mine = (j == x) ? c : mine; }
        if (sum == G) break;
        __builtin_amdgcn_s_sleep(1);
        if ((++sp & 255u) == 0u) { if (xb_ld(&bar[XB_TMO])) break; if (sp > XB_SPIN_CAP) { atomicAdd(&bar[XB_TMO], 1u); break; } }
    }
    nloc = mine > 0u ? mine : 1u; nx = cnt > 0u ? cnt : 1u;
}

__device__ __forceinline__ void xcd_barrier(const XcdBarrier& b) {
    asm volatile("s_waitcnt vmcnt(0)" ::: "memory");
    __syncthreads();
    if (threadIdx.x == 0) {
        unsigned* bar = b.bar;
        __builtin_amdgcn_s_waitcnt(0);
        unsigned nloc = b.st[0], nx = b.st[1];
        if (nloc == 0u) { xcd_barrier_complete(bar, b.x, nloc, nx); b.st[0] = nloc; b.st[1] = nx; }
        const unsigned old = xb_add(&bar[XB_XSUB(b.x)], 1u);
        const unsigned gen = old / nloc;
        if (old + 1u == (gen + 1u) * nloc) {
            __builtin_amdgcn_fence(__ATOMIC_RELEASE, "agent");
            asm volatile("s_waitcnt vmcnt(0)" ::: "memory");
            const unsigned og = xb_add(&bar[XB_TOP], 1u);
            const unsigned tg = og / nx;
            if (og + 1u == (tg + 1u) * nx) xb_add(&bar[XB_TOPGEN], 1u);
            else XB_SPIN(xb_ld(&bar[XB_TOPGEN]) == tg, bar);
            __builtin_amdgcn_fence(__ATOMIC_ACQUIRE, "agent");
            xb_add(&bar[XB_XGEN(b.x)], 1u);
            asm volatile("s_waitcnt vmcnt(0)" ::: "memory");
        } else {
            XB_SPIN(xb_ld(&bar[XB_XGEN(b.x)]) == gen, bar);
            __builtin_amdgcn_fence(__ATOMIC_ACQUIRE, "agent");
            asm volatile("s_waitcnt vmcnt(0)" ::: "memory");
        }
    }
    __syncthreads();
}

typedef unsigned u32x2 __attribute__((ext_vector_type(2)));
typedef float f32x2 __attribute__((ext_vector_type(2)));
#define MFMA16(a, b, c) __builtin_amdgcn_mfma_f32_16x16x32_bf16((a), (b), (c), 0, 0, 0)
__device__ __forceinline__ float wave_sum(float v) {
#pragma unroll
    for (int o = 1; o < 64; o <<= 1) v += __shfl_xor(v, o);
    return v;
}
__device__ __forceinline__ float bflo(unsigned w) { return __uint_as_float(w << 16); }
__device__ __forceinline__ float bfhi(unsigned w) { return __uint_as_float(w & 0xffff0000u); }
__device__ __forceinline__ unsigned pkbf(float lo, float hi) { return pg8::cvt_pk_bf16(lo, hi); }

struct Args { const float* in[19]; float* out; unsigned char* ws; int ph_lo, ph_hi; };

__device__ __forceinline__ void p0_transpose_item(const float* W, int K, int N, bf16* WT, int kb, int n0, int row0, int lane) {
    const GAS float* src = (const GAS float*)W + (size_t)(kb * 64) * N + n0 + lane;
    float v[64];
#pragma unroll
    for (int i = 0; i < 64; ++i) v[i] = src[(size_t)i * N];
    GAS v4u* dst = (GAS v4u*)((GAS bf16*)WT + (size_t)(row0 + lane) * K + kb * 64);
#pragma unroll
    for (int c = 0; c < 8; ++c) { v4u o; o.x = pkbf(v[8 * c], v[8 * c + 1]); o.y = pkbf(v[8 * c + 2], v[8 * c + 3]); o.z = pkbf(v[8 * c + 4], v[8 * c + 5]); o.w = pkbf(v[8 * c + 6], v[8 * c + 7]); dst[c] = o; }
}
__device__ __forceinline__ int gu_row0(int n0) {
    const int up = n0 >= DFF ? 1 : 0, j = n0 - up * DFF; return 256 * (j >> 7) + 128 * up + (j & 127);
}

template <int MODE> __device__ __forceinline__ void row_pass(int gw, int NGW, int lane, const void* src, const float* lg, const float* lb, float* Yf, bf16* Yb, bf16* H,
                                                             const float* ada, const float* bada, int seg_sh, int seg_sc) {
#define RP_F4(base, boff) (*(const GAS f32x4*)((const GAS char*)(base) + (boff)))
#define RP_U4(base, boff) (*(const GAS v4u*)((const GAS char*)(base) + (boff)))
    for (int row = gw; row < M; row += NGW) {
        const int b = row / SEQ;
        unsigned l16; asm volatile("v_lshlrev_b32 %0, 4, %1" : "=v"(l16) : "v"(lane));
        const unsigned l32 = 2u * l16;
        f32x4 v[8][2];
        if (MODE == 0) {
            const float* sp = (const float*)src + (size_t)row * D;
#pragma unroll
            for (int j = 0; j < 8; ++j) { v[j][0] = RP_F4(sp, 2048u * j + l32); v[j][1] = RP_F4(sp, 2048u * j + 16u + l32); }
        } else {
            const bf16* sp = (const bf16*)src + (size_t)row * D;
#pragma unroll
            for (int j = 0; j < 8; ++j) { const v4u w = RP_U4(sp, 1024u * j + l16); v[j][0] = (f32x4){bflo(w.x), bfhi(w.x), bflo(w.y), bfhi(w.y)}; v[j][1] = (f32x4){bflo(w.z), bfhi(w.z), bflo(w.w), bfhi(w.w)}; }
            float s = 0.f;
#pragma unroll
            for (int j = 0; j < 8; ++j) s += ((v[j][0].x + v[j][0].y) + (v[j][0].z + v[j][0].w)) + ((v[j][1].x + v[j][1].y) + (v[j][1].z + v[j][1].w));
            const float mean = wave_sum(s) * (1.f / D); float s2 = 0.f;
#pragma unroll
            for (int j = 0; j < 8; ++j)
#pragma unroll
                for (int q = 0; q < 2; ++q) { v[j][q] = v[j][q] - mean; s2 += (v[j][q].x * v[j][q].x + v[j][q].y * v[j][q].y) + (v[j][q].z * v[j][q].z + v[j][q].w * v[j][q].w); }
            const float rstd = 1.0f / sqrtf(wave_sum(s2) * (1.f / D) + LN_EPS);
            const float* ash = ada + (size_t)b * ADAW + seg_sh * D; const float* bsh = bada + seg_sh * D;
            const float* asc = ada + (size_t)b * ADAW + seg_sc * D; const float* bsc = bada + seg_sc * D;
            float* ypf = Yf + (size_t)row * D; bf16* ypb = Yb + (size_t)row * D; bf16* hp = H + (size_t)row * D;
#pragma unroll
            for (int j = 0; j < 8; ++j) {
                f32x4 y[2];
#pragma unroll
                for (int q = 0; q < 2; ++q) { const unsigned bo = 2048u * j + 16u * q + l32; y[q] = v[j][q] * rstd * RP_F4(lg, bo) + RP_F4(lb, bo); }
                if (MODE == 2) { *(GAS f32x4*)((GAS char*)ypf + (2048u * j + l32)) = y[0]; *(GAS f32x4*)((GAS char*)ypf + (2048u * j + 16u + l32)) = y[1]; }
                else {
                    v4u w; w.x = pkbf(y[0].x, y[0].y); w.y = pkbf(y[0].z, y[0].w); w.z = pkbf(y[1].x, y[1].y); w.w = pkbf(y[1].z, y[1].w); *(GAS v4u*)((GAS char*)ypb + (1024u * j + l16)) = w;
                    f32x4 o[2];
#pragma unroll
                    for (int q = 0; q < 2; ++q) { const unsigned bo = 2048u * j + 16u * q + l32; const f32x4 sh = RP_F4(ash, bo) + RP_F4(bsh, bo), sc = RP_F4(asc, bo) + RP_F4(bsc, bo) + 1.0f; o[q] = y[q] * sc + sh; }
                    v4u h; h.x = pkbf(o[0].x, o[0].y); h.y = pkbf(o[0].z, o[0].w); h.z = pkbf(o[1].x, o[1].y); h.w = pkbf(o[1].z, o[1].w); *(GAS v4u*)((GAS char*)hp + (1024u * j + l16)) = h;
                }
                if (j & 1) asm volatile("" ::: "memory");
            }
        }
        if (MODE == 0) {
            const float* ash = ada + (size_t)b * ADAW + seg_sh * D; const float* bsh = bada + seg_sh * D;
            const float* asc = ada + (size_t)b * ADAW + seg_sc * D; const float* bsc = bada + seg_sc * D;
            bf16* hp = H + (size_t)row * D;
#pragma unroll
            for (int j = 0; j < 8; ++j) { f32x4 o[2];
#pragma unroll
                for (int q = 0; q < 2; ++q) { const unsigned bo = 2048u * j + 16u * q + l32; const f32x4 sh = RP_F4(ash, bo) + RP_F4(bsh, bo), sc = RP_F4(asc, bo) + RP_F4(bsc, bo) + 1.0f; o[q] = v[j][q] * sc + sh; }
                v4u w; w.x = pkbf(o[0].x, o[0].y); w.y = pkbf(o[0].z, o[0].w); w.z = pkbf(o[1].x, o[1].y); w.w = pkbf(o[1].z, o[1].w); *(GAS v4u*)((GAS char*)hp + (1024u * j + l16)) = w; if ((j & 3) == 3) asm volatile("" ::: "memory"); }
        }
    }
#undef RP_F4
#undef RP_U4
}

__device__ __forceinline__ void ret_state_unit(int lane, int wave, int bh, int es, const bf16* KT, const bf16* VT, bf16* RG) {
    const int b = bh >> 3, h = bh & 7, e0 = es * 16, i = lane & 15, g = lane >> 4;
    const float l2g = pg8::log2_gamma(h);
    const float gam = __builtin_amdgcn_exp2f(l2g), g127 = __builtin_amdgcn_exp2f(127.0f * l2g), g128 = __builtin_amdgcn_exp2f(128.0f * l2g);
    const GAS bf16* KTp = (const GAS bf16*)KT + ((size_t)bh * 32 * 256 + 32 * wave + i) * 128 + 8 * g;
    const GAS bf16* VTp = (const GAS bf16*)VT + ((size_t)bh * 32 * 256 + e0 + i) * 128 + 8 * g;
    GAS bf16* Rp = (GAS bf16*)RG + ((size_t)bh * 32 * 256 + e0 + i) * 256 + 32 * wave + 4 * g;
    f32x4 st[2]; st[0] = (f32x4){0.f, 0.f, 0.f, 0.f}; st[1] = st[0];
    bf16x8 vf[3][4], kt[3][2][4];
#define RS_LOAD(cc, sl) do { const int tn_ = ((cc) < SEQ / CHK ? (cc) : SEQ / CHK - 1) * 32768; \
        _Pragma("unroll") for (int s = 0; s < 4; ++s) vf[sl][s] = *(const GAS bf16x8*)(VTp + tn_ + 32 * s); \
        _Pragma("unroll") for (int t = 0; t < 2; ++t) _Pragma("unroll") for (int s = 0; s < 4; ++s) kt[sl][t][s] = *(const GAS bf16x8*)(KTp + (16 * t) * 128 + tn_ + 32 * s); } while (0)
    RS_LOAD(0, 0); RS_LOAD(1, 1);
    for (int c3 = 0; c3 < SEQ / CHK; c3 += 3) {
#pragma unroll
        for (int u = 0; u < 3; ++u) {
            const int c = c3 + u;
            if (c >= SEQ / CHK) break;
            RS_LOAD(c + 2, (u + 2) % 3);
#pragma unroll
            for (int t = 0; t < 2; ++t) {
                u32x2 w; w.x = pkbf(gam * st[t][0], gam * st[t][1]); w.y = pkbf(gam * st[t][2], gam * st[t][3]);
                *(GAS u32x2*)(Rp + (size_t)c * 65536 + 16 * t) = w;
                f32x4 tmp = (f32x4){0.f, 0.f, 0.f, 0.f};
#pragma unroll
                for (int s = 0; s < 4; ++s) tmp = MFMA16(kt[u][t][s], vf[u][s], tmp);
                st[t] = st[t] * g128 + tmp * g127;
            }
        }
    }
#undef RS_LOAD
}
__device__ __forceinline__ void ret_out_unit(LAS unsigned char* lds, int tid, int lane, int wave, int bh, int c, const bf16* Q, const bf16* K, const bf16* VT, const bf16* RG, const bf16* GS, bf16* RETG) {
    constexpr int KQ_OFF = 0, KQ_PITCH = 528, PL_OFF = 128 * KQ_PITCH, PL_PITCH = 272, ST_OFF = PL_OFF + 128 * PL_PITCH;
    static_assert(ST_OFF + 128 * 8 * 8 <= RING_BYTES, "retention LDS");
    const int b = bh >> 3, h = bh & 7, i = lane & 15, g = lane >> 4, rb = wave, tok0 = b * SEQ + c * CHK;
    const GAS bf16* Qp = (const GAS bf16*)Q + (size_t)tok0 * RW + 256 * h;
    const GAS bf16* Kp = (const GAS bf16*)K + (size_t)tok0 * RW + 256 * h;
    v4u kreg[8];
#pragma unroll
    for (int q = 0; q < 8; ++q) { const int idx = tid + 512 * q, row = idx >> 5, c16 = idx & 31; kreg[q] = *(const GAS v4u*)(Kp + (size_t)row * RW + c16 * 8); }
    bf16x8 qf[8];
#pragma unroll
    for (int s = 0; s < 8; ++s) qf[s] = *(const GAS bf16x8*)(Qp + (size_t)(16 * rb + i) * RW + 32 * s + 8 * g);
#pragma unroll
    for (int q = 0; q < 8; ++q) { const int idx = tid + 512 * q, row = idx >> 5, c16 = idx & 31; *(LAS v4u*)(lds + KQ_OFF + row * KQ_PITCH + c16 * 16) = kreg[q]; }
    __syncthreads();
#pragma unroll
    for (int q = 0; q < 8; ++q) { const int idx = tid + 512 * q, row = idx >> 5, c16 = idx & 31; kreg[q] = *(const GAS v4u*)(Qp + (size_t)row * RW + c16 * 8); }
    bf16x8 vf[2][4], rf[2][8];
    {
        const GAS bf16* VTp = (const GAS bf16*)VT + (((size_t)bh * 32 + c) * 256 + 32 * wave + i) * 128 + 8 * g;
        const GAS bf16* RGp = (const GAS bf16*)RG + (((size_t)bh * 32 + c) * 256 + 32 * wave + i) * 256 + 8 * g;
#pragma unroll
        for (int t = 0; t < 2; ++t) {
#pragma unroll
            for (int s = 0; s < 4; ++s) vf[t][s] = *(const GAS bf16x8*)(VTp + (16 * t) * 128 + 32 * s);
#pragma unroll
            for (int s = 0; s < 8; ++s) rf[t][s] = *(const GAS bf16x8*)(RGp + (size_t)(16 * t) * 256 + 32 * s);
        }
    }
    for (int j = 0; j <= rb; ++j) {
        f32x4 acc = (f32x4){0.f, 0.f, 0.f, 0.f};
#pragma unroll
        for (int s = 0; s < 8; ++s) { const bf16x8 a = *(const LAS bf16x8*)(lds + KQ_OFF + (16 * j + i) * KQ_PITCH + (32 * s + 8 * g) * 2); acc = MFMA16(a, qf[s], acc); }
        if (j == rb) {
#pragma unroll
            for (int r = 0; r < 4; ++r) if (4 * g + r > i) acc[r] = 0.f;
        }
        u32x2 w; w.x = pkbf(acc[0], acc[1]); w.y = pkbf(acc[2], acc[3]);
        *(LAS u32x2*)(lds + PL_OFF + (16 * rb + i) * PL_PITCH + (16 * j + 4 * g) * 2) = w;
    }
    if ((rb & 1) == 0) { u32x2 z; z.x = 0u; z.y = 0u; *(LAS u32x2*)(lds + PL_OFF + (16 * rb + i) * PL_PITCH + (16 * (rb + 1) + 4 * g) * 2) = z; }
    __syncthreads();
#pragma unroll
    for (int q = 0; q < 8; ++q) { const int idx = tid + 512 * q, row = idx >> 5, c16 = idx & 31; *(LAS v4u*)(lds + KQ_OFF + row * KQ_PITCH + c16 * 16) = kreg[q]; }
    __syncthreads();
    f32x4 o[8][2];
#pragma unroll
    for (int nb = 0; nb < 8; ++nb) {
        o[nb][0] = (f32x4){0.f, 0.f, 0.f, 0.f}; o[nb][1] = o[nb][0];
#pragma unroll
        for (int s = 0; s < 4; ++s) if (s <= (nb >> 1)) {
            const bf16x8 p = *(const LAS bf16x8*)(lds + PL_OFF + (16 * nb + i) * PL_PITCH + (32 * s + 8 * g) * 2);
            o[nb][0] = MFMA16(vf[0][s], p, o[nb][0]); o[nb][1] = MFMA16(vf[1][s], p, o[nb][1]); }
#pragma unroll
        for (int s = 0; s < 8; ++s) {
            const bf16x8 qq = *(const LAS bf16x8*)(lds + KQ_OFF + (16 * nb + i) * KQ_PITCH + (32 * s + 8 * g) * 2);
            o[nb][0] = MFMA16(rf[0][s], qq, o[nb][0]); o[nb][1] = MFMA16(rf[1][s], qq, o[nb][1]); }
    }
    LAS f32x2* ST = (LAS f32x2*)(lds + ST_OFF);
#pragma unroll
    for (int nb = 0; nb < 8; ++nb) {
        float s1 = 0.f, s2 = 0.f;
#pragma unroll
        for (int t = 0; t < 2; ++t)
#pragma unroll
            for (int r = 0; r < 4; ++r) { const float v = o[nb][t][r]; s1 += v; s2 += v * v; }
        s1 += __shfl_xor(s1, 16); s1 += __shfl_xor(s1, 32); s2 += __shfl_xor(s2, 16); s2 += __shfl_xor(s2, 32);
        if (g == 0) { f32x2 v; v.x = s1; v.y = s2; ST[(16 * nb + i) * 8 + wave] = v; }
    }
    __syncthreads();
#pragma unroll
    for (int nb = 0; nb < 8; ++nb) {
        float s1 = 0.f, s2 = 0.f;
#pragma unroll
        for (int w = 0; w < 8; ++w) { const f32x2 v = ST[(16 * nb + i) * 8 + w]; s1 += v.x; s2 += v.y; }
        const float mean = s1 * (1.f / HD), var = fmaxf(s2 * (1.f / HD) - mean * mean, 0.f), rstd = 1.0f / sqrtf(var + LN_EPS);
        const size_t rowoff = (size_t)(tok0 + 16 * nb + i) * RW + 256 * h + 32 * wave + 4 * g;
#pragma unroll
        for (int t = 0; t < 2; ++t) {
            const u32x2 gwv = *(const GAS u32x2*)(GS + rowoff + 16 * t);
            const f32x4 y = (o[nb][t] - mean) * rstd * (f32x4){bflo(gwv.x), bfhi(gwv.x), bflo(gwv.y), bfhi(gwv.y)};
            u32x2 w; w.x = pkbf(y[0], y[1]); w.y = pkbf(y[2], y[3]); *(GAS u32x2*)(RETG + rowoff + 16 * t) = w;
        }
    }
    __syncthreads();
}

__device__ __forceinline__ void sg_unit(LAS unsigned char* lds, int tid, int lane, int wave, int ck, int grp, const float* sgw, const float* sgb, const float* lng, const float* lnb,
                                        const float* stats, const bf16* ST, const bf16* UG, bf16* SGU) {
    constexpr int WL_OFF = 0, WL_PITCH = 272, MU_OFF = 128 * WL_PITCH, RS_OFF = MU_OFF + 512, C1_OFF = RS_OFF + 512, C2_OFF = C1_OFF + 512, BS_OFF = C2_OFF + 512;
    const int tok0 = ck * CHK;
    LAS float* MU = (LAS float*)(lds + MU_OFF); LAS float* RS = (LAS float*)(lds + RS_OFF); LAS float* C1 = (LAS float*)(lds + C1_OFF); LAS float* C2 = (LAS float*)(lds + C2_OFF); LAS float* BS = (LAS float*)(lds + BS_OFF);
    if (tid < CHK) {
        const GAS f32x2* sp = (const GAS f32x2*)(stats + (size_t)(tok0 + tid) * 64); float s = 0.f, q = 0.f;
#pragma unroll 8
        for (int p = 0; p < 32; ++p) { const f32x2 v = sp[p]; s += v.x; q += v.y; }
        const float mean = s * (1.f / SGW), var = fmaxf(q * (1.f / SGW) - mean * mean, 0.f);
        MU[tid] = mean; RS[tid] = 1.0f / sqrtf(var + LN_EPS);
    }
    __syncthreads();
    {
        const int t = tid >> 2, sq = tid & 3; const GAS float* wrow = (const GAS float*)sgw + ((size_t)grp * CHK + t) * CHK + 32 * sq;
        float c1 = 0.f, c2 = 0.f;
#pragma unroll
        for (int j = 0; j < 32; j += 2) { const int s = 32 * sq + j; const float w0 = (s <= t) ? wrow[j] : 0.f, w1 = (s + 1 <= t) ? wrow[j + 1] : 0.f;
            const float a0 = w0 * RS[s], a1 = w1 * RS[s + 1]; c2 += w0 + w1; c1 += a0 * MU[s] + a1 * MU[s + 1];
            *(LAS unsigned*)(lds + WL_OFF + t * WL_PITCH + s * 2) = pkbf(a0, a1); }
        c1 += __shfl_xor(c1, 1); c1 += __shfl_xor(c1, 2); c2 += __shfl_xor(c2, 1); c2 += __shfl_xor(c2, 2);
        if (sq == 0) { C1[t] = c1; C2[t] = c2; BS[t] = sgb[grp * CHK + t]; }
    }
    __syncthreads();
    const int i = lane & 15, g = lane >> 4, trow = 16 * wave + i, nsteps = (wave >> 1) + 1;
    bf16x8 wf[4];
#pragma unroll
    for (int s = 0; s < 4; ++s) wf[s] = *(const LAS bf16x8*)(lds + WL_OFF + trow * WL_PITCH + (32 * s + 8 * g) * 2);
    const float c1t = C1[trow], c2t = C2[trow], bst = BS[trow];
    bf16x8 af[3][4]; f32x4 lgv[3], lbv[3]; u32x2 uwv[3];
    const GAS bf16* spb = (const GAS bf16*)ST + ((size_t)ck * SGW + GD * grp + i) * 128 + 8 * g;
    const int chb = GD * grp + 4 * g;
    const GAS bf16* ugp = (const GAS bf16*)UG + (size_t)(tok0 + trow) * SGW + chb;
    GAS bf16* sgp = (GAS bf16*)SGU + (size_t)(tok0 + trow) * SGW + chb;
#define SG_LOAD(j, sl) do { _Pragma("unroll") for (int s = 0; s < 4; ++s) if (s < nsteps) af[sl][s] = *(const GAS bf16x8*)(spb + (16 * (j)) * 128 + 32 * s); \
        lgv[sl] = *(const GAS f32x4*)(lng + chb + 16 * (j)); lbv[sl] = *(const GAS f32x4*)(lnb + chb + 16 * (j)); uwv[sl] = *(const GAS u32x2*)(ugp + 16 * (j)); } while (0)
    SG_LOAD(0, 0); SG_LOAD(1, 1);
#pragma unroll
    for (int j = 0; j < 16; ++j) {
        if (j + 2 < 16) SG_LOAD(j + 2, (j + 2) % 3);
        const int sl = j % 3;
        f32x4 acc = (f32x4){0.f, 0.f, 0.f, 0.f};
#pragma unroll
        for (int s = 0; s < 4; ++s) if (s < nsteps) acc = MFMA16(af[sl][s], wf[s], acc);
        const f32x4 uv = (f32x4){bflo(uwv[sl].x), bfhi(uwv[sl].x), bflo(uwv[sl].y), bfhi(uwv[sl].y)};
        const f32x4 val = uv * (lgv[sl] * (acc - c1t) + lbv[sl] * c2t + bst);
        u32x2 w; w.x = pkbf(val[0], val[1]); w.y = pkbf(val[2], val[3]);
        *(GAS u32x2*)(sgp + 16 * j) = w;
    }
#undef SG_LOAD
    __syncthreads();
}

__global__ void __launch_bounds__(NWAVES * 64, 2) fwd(Args args) {
    extern __shared__ __attribute__((aligned(16))) unsigned char lds_raw[];
    LAS unsigned char* lds = (LAS unsigned char*)lds_raw;
    volatile LAS unsigned* MISC = (volatile LAS unsigned*)(lds + MISC_OFF);
    const int tid = threadIdx.x, lane = tid & 63, wave = __builtin_amdgcn_readfirstlane(tid >> 6);
    const int G = gridDim.x, bx = blockIdx.x, vcu = (G % 8 == 0) ? (bx % 8) * (G / 8) + bx / 8 : bx;
    const int gw = vcu * NWAVES + wave, NGW = G * NWAVES;
    unsigned char* ws = args.ws;
    unsigned* ctl = (unsigned*)(ws + WS_CTL);
    const float* x = args.in[0]; const float* cin = args.in[1]; const int* pos = (const int*)args.in[2]; const float* w_ada = args.in[3]; const float* b_ada = args.in[4];
    const float* w_in = args.in[5]; const float* sg_ln_g = args.in[6]; const float* sg_ln_b = args.in[7]; const float* sg_w = args.in[8]; const float* sg_b = args.in[9];
    const float* w_ret_up = args.in[10]; const float* w_sg_up = args.in[11]; const float* w_out = args.in[12]; const float* ln1_g = args.in[13]; const float* ln1_b = args.in[14];
    const float* w_gate_up = args.in[15]; const float* w_down = args.in[16]; const float* ln2_g = args.in[17]; const float* ln2_b = args.in[18];
    float* ada = (float*)(ctl + CW_ADA);
    float* cosT = (float*)(ws + WS_COS); float* sinT = (float*)(ws + WS_SIN); float* stats = (float*)(ws + WS_STATS);
    bf16 *WIN = (bf16*)(ws + WS_WIN), *WRET = (bf16*)(ws + WS_WRET), *WSG = (bf16*)(ws + WS_WSG), *WOUT = (bf16*)(ws + WS_WOUT), *WGU = (bf16*)(ws + WS_WGU), *WDN = (bf16*)(ws + WS_WDN);
    bf16 *H = (bf16*)(ws + WS_H), *Qb = (bf16*)(ws + WS_Q), *Kb = (bf16*)(ws + WS_K), *KTb = (bf16*)(ws + WS_KT), *VTb = (bf16*)(ws + WS_VT), *GSb = (bf16*)(ws + WS_GS), *UGb = (bf16*)(ws + WS_UG), *STb = (bf16*)(ws + WS_ST);
    bf16 *SIGR = (bf16*)(ws + WS_SIGR), *SIGS = (bf16*)(ws + WS_SIGS), *RETG = (bf16*)(ws + WS_RETG), *SGU = (bf16*)(ws + WS_SGU), *MIX = (bf16*)(ws + WS_MIX), *ACT = (bf16*)(ws + WS_ACT);
    bf16* RGb = (bf16*)(ws + WS_RET);
    float* PRE = (float*)(ws + WS_PRE);
    bf16 *PREb = (bf16*)(ws + WS_X1), *X1b = (bf16*)(ws + WS_X1 + 64 * MiB);

    for (int u = tid; u < (LDS_BYTES - LDSCTL_OFF) / 4; u += NWAVES * 64) ((LAS unsigned*)(lds + LDSCTL_OFF))[u] = 0u;
    __syncthreads();
    XcdBarrier bar; bar.bar = ctl + CW_BAR; bar.x = 0; bar.st = nullptr;
    if (MK_N_LAUNCHES == 1) bar = xcd_barrier_post(ctl + CW_BAR, MISC + 8);
    const int lo = args.ph_lo, hi = args.ph_hi;
#ifdef GP_STAMP
    unsigned long long* prb = (unsigned long long*)(ctl + 32768);
    unsigned long long gp_prev = __builtin_amdgcn_s_memrealtime();
#define PSTAMP(k) do { if (bx == 0 && tid == 0) { const unsigned long long now_ = __builtin_amdgcn_s_memrealtime(); prb[64 + (k)] = now_ - gp_prev; gp_prev = now_; } } while (0)
#define SPRB(k) S.prb = prb + 4 * (k);
#else
#define PSTAMP(k) do {} while (0)
#define SPRB(k)
#endif
#ifndef PH_MASK
#ifdef DBG_STOP
#define PH_MASK (((2u << DBG_STOP) - 1u) | 0x800u)
#else
#define PH_MASK 0xfff
#endif
#endif
#define IN(k) (((PH_MASK >> (k)) & 1) && lo <= (k) && (k) < hi)
#define SEAM(k) do { if (IN(k) && IN((k) + 1)) xcd_barrier(bar); PSTAMP(k); } while (0)
#ifndef DUP_MASK
#define DUP_MASK 0
#endif
#define REP(k) for (int rep_ = 0; rep_ < (((DUP_MASK >> (k)) & 1) ? 2 : 1); ++rep_)

    if (IN(0)) REP(0) {
        LAS float* scl = (LAS float*)(lds + RING_OFF);
        for (int u = tid; u < BATCH * D; u += NWAVES * 64) { const float v = cin[u]; scl[u] = v / (1.0f + expf(-v)); }
        __syncthreads();
        for (int cb = vcu; cb < ADAW / 96; cb += G) {
            const int half = lane / 24, c4 = lane - 24 * half;
            f32x4 a0 = (f32x4){0.f, 0.f, 0.f, 0.f}, a1 = a0;
            if (lane < 48) {
                const GAS float* wp = (const GAS float*)w_ada + (size_t)(512 * wave + half) * ADAW + cb * 96 + 4 * c4;
#pragma unroll 8
                for (int kk = 0; kk < 256; ++kk) { const f32x4 w = *(const GAS f32x4*)(wp + (size_t)(2 * kk) * ADAW); const int k = 512 * wave + 2 * kk + half; const float s0 = scl[k], s1 = scl[D + k]; a0 += w * s0; a1 += w * s1; }
            }
            LAS f32x4* red = (LAS f32x4*)(lds + RING_OFF + 32768);
            if (lane < 48) { red[(wave * 48 + lane) * 2] = a0; red[(wave * 48 + lane) * 2 + 1] = a1; }
            __syncthreads();
            if (tid < 48) {
                const int bsel = tid / 24, cc = tid - 24 * bsel; f32x4 s = (f32x4){0.f, 0.f, 0.f, 0.f};
#pragma unroll
                for (int w = 0; w < 8; ++w) { s += red[(w * 48 + cc) * 2 + bsel]; s += red[(w * 48 + 24 + cc) * 2 + bsel]; }
                *(GAS f32x4*)(ada + (size_t)bsel * ADAW + cb * 96 + 4 * cc) = s;
            }
            __syncthreads();
        }
        {
            constexpr int I0 = (D / 64) * (INW / 64), I1 = (RW / 64) * (D / 64), I2 = I1, I3 = (D / 64) * (D / 64), I4 = (D / 64) * (2 * DFF / 64), I5 = (DFF / 64) * (D / 64);
            constexpr int NIT = I0 + I1 + I2 + I3 + I4 + I5;
            for (int it = gw; it < NIT; it += NGW) {
                int r = it;
                if (r < I0) { p0_transpose_item(w_in, D, INW, WIN, r % (D / 64), (r / (D / 64)) * 64, (r / (D / 64)) * 64, lane); continue; } r -= I0;
                if (r < I1) { p0_transpose_item(w_ret_up, RW, D, WRET, r % (RW / 64), (r / (RW / 64)) * 64, (r / (RW / 64)) * 64, lane); continue; } r -= I1;
                if (r < I2) { p0_transpose_item(w_sg_up, SGW, D, WSG, r % (SGW / 64), (r / (SGW / 64)) * 64, (r / (SGW / 64)) * 64, lane); continue; } r -= I2;
                if (r < I3) { p0_transpose_item(w_out, D, D, WOUT, r % (D / 64), (r / (D / 64)) * 64, (r / (D / 64)) * 64, lane); continue; } r -= I3;
                if (r < I4) { const int n0 = (r / (D / 64)) * 64; p0_transpose_item(w_gate_up, D, 2 * DFF, WGU, r % (D / 64), n0, gu_row0(n0), lane); continue; } r -= I4;
                p0_transpose_item(w_down, DFF, D, WDN, r % (DFF / 64), (r / (DFF / 64)) * 64, (r / (DFF / 64)) * 64, lane);
            }
        }
        for (int e = (vcu * NWAVES * 64 + tid); e < M * 128; e += G * NWAVES * 64) {
            const int row = e >> 7, j = e & 127;
            const float inv = (float)exp2(-(double)j * (13.287712379549449 / 128.0));
            const float angf = (float)pos[row] * inv;
            const double a = (double)angf; const double rr = a - 6.283185307179586476925 * rint(a * 0.15915494309189533577);
            cosT[e] = cosf((float)rr); sinT[e] = sinf((float)rr);
        }
        __syncthreads();
    }
    SEAM(0);
    if (IN(1)) REP(1) row_pass<0>(gw, NGW, lane, x, nullptr, nullptr, nullptr, nullptr, H, ada, b_ada, 0, 1);
    SEAM(1);
    if (IN(2)) REP(2) {
        pg8::Gemm g{H, WIN, M, INW, D}; pg8::StaticOrder S; S.init(M, INW, G, bx); SPRB(2)
        pg8::EpiZ E{ws, stats, cosT, sinT};
        pg8::gemm_phase<pg8::EpiZ, pg8::StaticOrder, true, true>(lds + RING_OFF, g, S, E);
    }
    SEAM(2);
    if (IN(3)) REP(3) {
#ifndef DUP_SUB
#define DUP_SUB 0
#endif
        for (int rr = 0; rr < ((DUP_SUB & 1) ? 2 : 1); ++rr)
        for (int uid = vcu; uid < 256; uid += G) ret_state_unit(lane, wave, uid >> 4, uid & 15, KTb, VTb, RGb);
        for (int rr = 0; rr < ((DUP_SUB & 2) ? 2 : 1); ++rr)
        for (int uid = vcu; uid < 512; uid += G) sg_unit(lds + RING_OFF, tid, lane, wave, uid >> 3, uid & 7, sg_w, sg_b, sg_ln_g, sg_ln_b, stats, STb, UGb, SGU);
    }
    SEAM(3);
    if (IN(4)) REP(4) {
        for (int uid = vcu; uid < 512; uid += G) ret_out_unit(lds + RING_OFF, tid, lane, wave, uid >> 5, uid & 31, Qb, Kb, VTb, RGb, GSb, RETG);
    }
    SEAM(4);
    if (IN(5)) REP(5) {
        pg8::Gemm g{RETG, WRET, M, D, RW}; pg8::StaticOrder S; S.init(M, D, G, bx); SPRB(5)
        pg8::EpiMix<0> E{SIGR, PRE, nullptr, D};
        pg8::gemm_phase<pg8::EpiMix<0>, pg8::StaticOrder, true, true>(lds + RING_OFF, g, S, E);
    }
    SEAM(5);
    if (IN(6)) REP(6) {
        pg8::Gemm g{SGU, WSG, M, D, SGW}; pg8::StaticOrder S; S.init(M, D, G, bx); SPRB(6)
        pg8::EpiMix<1> E{SIGS, PRE, MIX, D};
        pg8::gemm_phase<pg8::EpiMix<1>, pg8::StaticOrder, true, true>(lds + RING_OFF, g, S, E);
    }
    SEAM(6);
    if (IN(7)) REP(7) {
        pg8::Gemm g{MIX, WOUT, M, D, D}; pg8::StaticOrder S; S.init(M, D, G, bx); SPRB(7)
        pg8::EpiRes<false> E{x, PREb, D, ada + 2 * D, b_ada + 2 * D, ADAW, SEQ, ALPHA};
        pg8::gemm_phase<pg8::EpiRes<false>, pg8::StaticOrder, true, true>(lds + RING_OFF, g, S, E);
    }
    SEAM(7);
    if (IN(8)) REP(8) row_pass<1>(gw, NGW, lane, PREb, ln1_g, ln1_b, nullptr, X1b, H, ada, b_ada, 3, 4);
    SEAM(8);
#ifdef PROBE_NULL9
    if (IN(9)) {
        pg8::Gemm g{H, WGU, M, 2 * DFF, D}; pg8::StaticOrder S; S.init(M, 2 * DFF, G, bx);
        pg8::EpiNull E{(float*)(ws + WS_STATS)};
        pg8::gemm_phase<pg8::EpiNull, pg8::StaticOrder, true, true>(lds + RING_OFF, g, S, E);
    }
#endif
    if (IN(9)) REP(9) {
        pg8::Gemm g{H, WGU, M, 2 * DFF, D}; pg8::StaticOrder S; S.init(M, 2 * DFF, G, bx); SPRB(9)
        pg8::EpiSwiGLU E{ACT, DFF};
        pg8::gemm_phase<pg8::EpiSwiGLU, pg8::StaticOrder, true, true>(lds + RING_OFF, g, S, E);
    }
    SEAM(9);
    if (IN(10)) REP(10) {
        pg8::Gemm g{ACT, WDN, M, D, DFF}; pg8::StaticOrder S; S.init(M, D, G, bx); SPRB(10)
        pg8::EpiRes<true> E{X1b, PREb, D, ada + 5 * D, b_ada + 5 * D, ADAW, SEQ, ALPHA};
        pg8::gemm_phase<pg8::EpiRes<true>, pg8::StaticOrder, true, true>(lds + RING_OFF, g, S, E);
    }
    SEAM(10);
#ifndef DBG_STOP
    if (IN(11)) REP(11) row_pass<2>(gw, NGW, lane, PREb, ln2_g, ln2_b, args.out, nullptr, nullptr, nullptr, nullptr, 0, 0);
#else
    if (IN(11)) {
        const size_t NT = (size_t)G * NWAVES * 64, NE = (size_t)M * D, HN = (size_t)M * 2048;
        for (size_t e = (size_t)vcu * NWAVES * 64 + tid; e < NE; e += NT) {
            float s = 0.f; const size_t eh = e % HN;
            if (DBG_STOP == 1) { s = bflo((unsigned)H[e]) ; }
            if (DBG_STOP == 0) { s = bflo((unsigned)WIN[e]) + bflo((unsigned)WIN[e + NE]) + bflo((unsigned)WGU[e]) + bflo((unsigned)WGU[e + NE]) + bflo((unsigned)WDN[e]) + bflo((unsigned)WOUT[e % ((size_t)D * D)]) + bflo((unsigned)WRET[eh % ((size_t)D * RW)]) + bflo((unsigned)WSG[eh % ((size_t)D * RW)]) + cosT[e % ((size_t)M * 128)] + sinT[e % ((size_t)M * 128)] + ada[e % (2 * ADAW)]; }
            if (DBG_STOP == 2) { s = bflo((unsigned)Qb[eh]) + bflo((unsigned)Kb[eh]) + bflo((unsigned)KTb[eh]) + bflo((unsigned)VTb[eh]) + bflo((unsigned)GSb[eh]) + bflo((unsigned)UGb[eh]) + bflo((unsigned)STb[eh]) + bflo((unsigned)SIGR[e]) + bflo((unsigned)SIGS[e]) + stats[e % ((size_t)M * 64)]; }
#ifndef DBG_P3
#define DBG_P3 3
#endif
            if (DBG_STOP == 3) { s = ((DBG_P3 & 1) ? bflo((unsigned)RGb[e]) : 0.f) + ((DBG_P3 & 2) ? bflo((unsigned)SGU[eh]) : 0.f); }
            if (DBG_STOP == 4) { s = bflo((unsigned)RETG[eh]); }
            if (DBG_STOP == 6) { s = bflo((unsigned)MIX[e]); }
            if (DBG_STOP == 7) { s = bflo((unsigned)PREb[e]); }
            if (DBG_STOP == 8) { s = bflo((unsigned)X1b[e]) + bflo((unsigned)H[e]); }
            if (DBG_STOP == 9) { s = bflo((unsigned)ACT[e]) + bflo((unsigned)ACT[e + NE]); }
            if (DBG_STOP == 10) { s = bflo((unsigned)PREb[e]); }
            args.out[e] = s;
        }
    }
#endif
#ifdef GP_STAMP
    PSTAMP(11);
    if (bx == 0 && tid == 0 && IN(11)) { args.out[0] += (float)prb[PRB_A] * 0.01f; args.out[1] += (float)prb[PRB_B] * 0.01f; }
#endif
#undef IN
#undef SEAM
}

extern "C" void kernel_launch(void* const* d_in, const int* in_sizes, int n_in, void* d_out, int out_size, void* d_ws, size_t ws_size, hipStream_t stream) {
    static int grid = 0;
    if (grid == 0) {
        if (n_in != 19 || in_sizes[0] != M * D || out_size != M * D || ws_size < WS_END) { fprintf(stderr, "kernel_launch: unexpected shapes (n_in %d, in0 %d, out %d, ws %zu)\n", n_in, n_in > 0 ? in_sizes[0] : -1, out_size, ws_size); grid = -1; return; }
        int dev = 0, cus = 0, per_cu = 0;
        if (hipGetDevice(&dev) != hipSuccess || hipDeviceGetAttribute(&cus, hipDeviceAttributeMultiprocessorCount, dev) != hipSuccess) { grid = -1; return; }
        if (hipFuncSetAttribute((const void*)fwd, hipFuncAttributeMaxDynamicSharedMemorySize, LDS_BYTES) != hipSuccess) { fprintf(stderr, "kernel_launch: hipFuncSetAttribute failed\n"); grid = -1; return; }
        if (hipOccupancyMaxActiveBlocksPerMultiprocessor(&per_cu, (const void*)fwd, NWAVES * 64, LDS_BYTES) != hipSuccess || per_cu < 1) fprintf(stderr, "kernel_launch: occupancy query reports %d\n", per_cu);
        (void)hipGetLastError();
        grid = cus;
    }
    if (grid < 0) return;
    if (hipMemsetAsync((char*)d_ws + WS_CTL, 0, CTL_ZERO_BYTES, stream) != hipSuccess) { fprintf(stderr, "kernel_launch: memset failed\n"); return; }
    Args a{};
    for (int i = 0; i < 19; ++i) a.in[i] = (const float*)d_in[i];
    a.out = (float*)d_out; a.ws = (unsigned char*)d_ws;
    if (MK_N_LAUNCHES == 1) { a.ph_lo = 0; a.ph_hi = N_PHASES + 1; hipLaunchKernelGGL(fwd, dim3(grid), dim3(NWAVES * 64), LDS_BYTES, stream, a); }
    else for (int p = 0; p <= N_PHASES; ++p) { a.ph_lo = p; a.ph_hi = p + 1; hipLaunchKernelGGL(fwd, dim3(grid), dim3(NWAVES * 64), LDS_BYTES, stream, a); }
    const hipError_t le = hipPeekAtLastError();
    if (le != hipSuccess) fprintf(stderr, "kernel_launch: launch failed: %s\n", hipGetErrorName(le));
}
```

```cpp
#include <hip/hip_runtime.h>
#include <cstdio>
#include <cstdint>
constexpr int NWAVES = 8;
constexpr int BATCH = 2, SEQ = 4096, D = 4096, M = BATCH * SEQ;
constexpr int RW = 2048, NH = 8, HD = 256, SGW = 2048, NG = 8, GD = 256, CHK = 128, DFF = 11008, INW = 20480, ADAW = 6 * D;
constexpr float LN_EPS = 1e-5f;
constexpr float ALPHA = 1.189207115002721f;
#ifndef MK_N_LAUNCHES
#define MK_N_LAUNCHES 1
#endif
constexpr int N_PHASES = 11;

constexpr size_t MiB = 1u << 20;
constexpr size_t WS_CTL = 0, CTL_ZERO_BYTES = 1 * MiB;
constexpr size_t WS_COS = 1 * MiB, WS_SIN = 5 * MiB, WS_STATS = 9 * MiB;
constexpr size_t WS_WIN = 16 * MiB, WS_WRET = 176 * MiB, WS_WSG = 192 * MiB, WS_WOUT = 208 * MiB, WS_WGU = 240 * MiB, WS_WDN = 412 * MiB;
constexpr size_t WS_H = 498 * MiB, WS_Q = 562 * MiB, WS_K = 594 * MiB, WS_KT = 626 * MiB, WS_VT = 658 * MiB, WS_GS = 690 * MiB, WS_UG = 722 * MiB, WS_ST = 754 * MiB;
constexpr size_t WS_SIGR = 786 * MiB, WS_SIGS = 850 * MiB, WS_RET = 914 * MiB, WS_RETG = 978 * MiB, WS_SGU = 1010 * MiB, WS_MIX = 1042 * MiB, WS_PRE = 1106 * MiB, WS_X1 = 1234 * MiB;
constexpr size_t WS_ACT = 562 * MiB;
constexpr size_t WS_END = 1362 * MiB;
static_assert(WS_WGU + (size_t)2 * DFF * D * 2 <= WS_WDN && WS_WDN + (size_t)D * DFF * 2 <= WS_H && WS_ACT + (size_t)M * DFF * 2 <= WS_ST, "d_ws map");
constexpr int CW_BAR = 4096;
constexpr int CW_WQ = 16384;
constexpr int CW_ADA = 65536;
static_assert((CW_ADA + 2 * ADAW) * 4 <= (int)CTL_ZERO_BYTES, "ctl");

constexpr int RING_OFF = 0, RING_BYTES = 131072;
constexpr int LDSCTL_OFF = RING_BYTES, MISC_OFF = LDSCTL_OFF + 320;
constexpr int LDS_BYTES = 147456;

namespace pg8 {
#define PG8_LAS __attribute__((address_space(3)))
typedef unsigned short bf16_t;
typedef short bf16x8 __attribute__((ext_vector_type(8)));
typedef float f32x4 __attribute__((ext_vector_type(4)));
typedef unsigned u32x4 __attribute__((ext_vector_type(4)));
constexpr int BM = 256, BK = 64, HALF = 128, HTB = HALF * BK * 2  , STAGE_BYTES = 8 * HTB, NXCD = 8, WGM = 8;

__host__ __device__ __forceinline__ int lds_byte(int r, int c) { const int st = (r >> 4) * 2 + (c >> 5), rr = r & 15, cc = c & 31, ob = rr * 64 + cc * 2; return st * 1024 + (ob ^ (((ob >> 9) & 1) << 5)); }
__host__ __device__ __forceinline__ void stage_rc(int b, int& R, int& C) { const int st = b / 1024, sb = b % 1024, swz = sb ^ (((sb >> 9) & 1) << 5); R = (st >> 1) * 16 + swz / 64; C = (st & 1) * 32 + (swz % 64) / 2; }
__host__ __device__ __forceinline__ int perm32(int rho) { const int n = rho >> 4, i = rho & 15; return 8 * (i >> 2) + 4 * n + (i & 3); }

struct Unit { int pm, pn; };
struct Gemm { const bf16_t* A; const bf16_t* Bt; int M, N, K; };

struct StaticOrder {
    int nM, nN, nwg, G, c; unsigned long long* prb = nullptr;
    __host__ __device__ void init(int M, int N, int G_, int c_) { nM = M / BM; nN = N / BM; nwg = nM * nN; G = G_; c = c_; }
    __host__ __device__ bool next(int i, Unit& u) const {
        const long L = (long)i * G + c; if (L >= nwg) return false;
        int wgid = (int)L; { const int q = nwg / NXCD, r = nwg % NXCD, xcd = wgid % NXCD, off = wgid / NXCD; wgid = (xcd < r ? xcd * (q + 1) : r * (q + 1) + (xcd - r) * q) + off; }
        const int nig = WGM * nN, gid = wgid / nig, fm = gid * WGM, gsz = (nM - fm) < WGM ? (nM - fm) : WGM;
        u.pm = fm + ((wgid % nig) % gsz); u.pn = (wgid % nig) / gsz; return true;
    }
    __device__ __forceinline__ void a_ready(const Unit&) const {}
    __device__ __forceinline__ void done(const Unit&) const {}
};
typedef __bf16 bf16v2_t __attribute__((ext_vector_type(2)));
typedef float f32v2_t __attribute__((ext_vector_type(2)));
__device__ __forceinline__ unsigned cvt_pk_bf16(float lo, float hi) { const f32v2_t v = {lo, hi}; const bf16v2_t b = __builtin_convertvector(v, bf16v2_t); return __builtin_bit_cast(unsigned, b); }
typedef float f32x2 __attribute__((ext_vector_type(2)));
typedef unsigned u32x2 __attribute__((ext_vector_type(2)));
__device__ __forceinline__ float fast_sigmoid(float x) { return __builtin_amdgcn_rcpf(1.0f + __builtin_amdgcn_exp2f(-1.4426950408889634f * x)); }
__device__ __forceinline__ float fast_silu(float x) { return x * fast_sigmoid(x); }
__device__ __forceinline__ float gelu_tanh(float x) { const float y = 1.5957691216057308f * (x + 0.044715f * x * x * x); return x * fast_sigmoid(y); }
__device__ __forceinline__ float bf_lo(unsigned w) { return __uint_as_float(w << 16); }
__device__ __forceinline__ float bf_hi(unsigned w) { return __uint_as_float(w & 0xffff0000u); }

__host__ __device__ __forceinline__ int frag_off(int row, int k, int NS) { return ((((row >> 4) * NS + (k >> 5)) * 64 + ((k >> 3) & 3) * 16 + (row & 15)) << 3) + (k & 7); }
__device__ __forceinline__ float log2_gamma(int h) { const float xg = __builtin_amdgcn_exp2f(-5.0f - (float)h); const float x2 = xg * xg; return -1.4426950408889634f * (xg + x2 * 0.5f + x2 * xg * (1.0f / 3.0f) + x2 * x2 * 0.25f + x2 * x2 * xg * 0.2f); }
struct EpiZ {
    static constexpr bool PERM = true, AFTER_DRAIN = false;
    unsigned char* ws; float* stats; const float *cosT, *sinT;
    __device__ __forceinline__ void operator()(const f32x4 (&acc)[2][2][4][2], const Unit& u, int wr, int wc, int fr, int fq) const {
        const int pn = u.pn, row0 = u.pm * BM + wr * 64 + fr, cl = wc * 32 + 8 * fq;
        if (pn < 16) {
            const int h = pn & 7; const bool isk = pn >= 8;
            const float l2g = log2_gamma(h);
            bf16_t* dst = (bf16_t*)(ws + (isk ? WS_K : WS_Q));
#pragma unroll
            for (int ai = 0; ai < 2; ++ai)
#pragma unroll
                for (int m = 0; m < 4; ++m) {
                    const int r = row0 + ai * HALF + m * 16, nloc = r & 127;
                    const float sc = isk ? 0.0625f * __builtin_amdgcn_exp2f(-(float)nloc * l2g) : __builtin_amdgcn_exp2f((float)nloc * l2g);
                    const float* cp = cosT + (size_t)r * 128 + cl; const float* sp = sinT + (size_t)r * 128 + cl;
                    const f32x4 c0 = *(const f32x4*)cp, c1 = *(const f32x4*)(cp + 4), s0 = *(const f32x4*)sp, s1 = *(const f32x4*)(sp + 4);
                    const f32x4 xa = acc[ai][0][m][0], xb = acc[ai][0][m][1], ya = acc[ai][1][m][0], yb = acc[ai][1][m][1];
                    const f32x4 o1a = (xa * c0 - ya * s0) * sc, o1b = (xb * c1 - yb * s1) * sc, o2a = (ya * c0 + xa * s0) * sc, o2b = (yb * c1 + xb * s1) * sc;
                    u32x4 w1, w2; w1.x = cvt_pk_bf16(o1a[0], o1a[1]); w1.y = cvt_pk_bf16(o1a[2], o1a[3]); w1.z = cvt_pk_bf16(o1b[0], o1b[1]); w1.w = cvt_pk_bf16(o1b[2], o1b[3]);
                    w2.x = cvt_pk_bf16(o2a[0], o2a[1]); w2.y = cvt_pk_bf16(o2a[2], o2a[3]); w2.z = cvt_pk_bf16(o2b[0], o2b[1]); w2.w = cvt_pk_bf16(o2b[2], o2b[3]);
                    bf16_t* rowp = dst + (size_t)r * 2048 + 256 * h + cl;
                    *(u32x4*)rowp = w1; *(u32x4*)(rowp + 128) = w2;
                    if (isk) {
                        bf16_t* tb = (bf16_t*)(ws + WS_KT) + (size_t)(((r >> 12) * 8 + h) * 32 + ((r >> 7) & 31)) * 32768;
#pragma unroll
                        for (int q = 0; q < 4; ++q) { const unsigned a = w1[q], b = w2[q];
                            tb[frag_off(cl + 2 * q, r & 127, 4)] = (bf16_t)(a & 0xffffu); tb[frag_off(cl + 2 * q + 1, r & 127, 4)] = (bf16_t)(a >> 16);
                            tb[frag_off(128 + cl + 2 * q, r & 127, 4)] = (bf16_t)(b & 0xffffu); tb[frag_off(128 + cl + 2 * q + 1, r & 127, 4)] = (bf16_t)(b >> 16); }
                    }
                    asm volatile("" ::: "memory");
                }
        } else if (pn < 24 || (pn >= 40 && pn < 48)) {
            const bool iss = pn >= 40; bf16_t* T = (bf16_t*)(ws + (iss ? WS_ST : WS_VT)); const int ct = (iss ? pn - 40 : pn - 16) * 256;
#pragma unroll
            for (int ai = 0; ai < 2; ++ai)
#pragma unroll
                for (int m = 0; m < 4; ++m) {
                    const int r = row0 + ai * HALF + m * 16; float sum = 0.f, sq = 0.f;
#pragma unroll
                    for (int bj = 0; bj < 2; ++bj)
#pragma unroll
                        for (int n = 0; n < 2; ++n) {
                            f32x4 v = acc[ai][bj][m][n];
                            if (iss) { v[0] = gelu_tanh(v[0]); v[1] = gelu_tanh(v[1]); v[2] = gelu_tanh(v[2]); v[3] = gelu_tanh(v[3]); }
                            const unsigned a = cvt_pk_bf16(v[0], v[1]), b = cvt_pk_bf16(v[2], v[3]);
                            if (iss) { const float f0 = bf_lo(a), f1 = bf_hi(a), f2 = bf_lo(b), f3 = bf_hi(b); sum += (f0 + f1) + (f2 + f3); sq += (f0 * f0 + f1 * f1) + (f2 * f2 + f3 * f3); }
                            const int cc = ct + bj * HALF + cl + 4 * n, rr = iss ? cc : (cc & 255);
                            bf16_t* t = T + (iss ? (size_t)(r >> 7) * 262144 : (size_t)(((r >> 12) * 8 + (ct >> 8)) * 32 + ((r >> 7) & 31)) * 32768);
                            t[frag_off(rr, r & 127, 4)] = (bf16_t)(a & 0xffffu); t[frag_off(rr + 1, r & 127, 4)] = (bf16_t)(a >> 16); t[frag_off(rr + 2, r & 127, 4)] = (bf16_t)(b & 0xffffu); t[frag_off(rr + 3, r & 127, 4)] = (bf16_t)(b >> 16);
                        }
                    if (iss) {
                        sum += __shfl_xor(sum, 16); sum += __shfl_xor(sum, 32); sq += __shfl_xor(sq, 16); sq += __shfl_xor(sq, 32);
                        if (fq == 0) { f32x2 o; o.x = sum; o.y = sq; *(f32x2*)(stats + (size_t)r * 64 + ((pn - 40) * 4 + wc) * 2) = o; }
                    }
                    asm volatile("" ::: "memory");
                }
        } else {
            const int kind = pn < 32 ? 0 : (pn < 40 ? 1 : 2);
            size_t doff; int ldc, ct;
            if (pn < 32) { doff = WS_GS; ldc = 2048; ct = (pn - 24) * 256; } else if (pn < 40) { doff = WS_UG; ldc = 2048; ct = (pn - 32) * 256; }
            else if (pn < 64) { doff = WS_SIGR; ldc = 4096; ct = (pn - 48) * 256; } else { doff = WS_SIGS; ldc = 4096; ct = (pn - 64) * 256; }
            bf16_t* dst = (bf16_t*)(ws + doff);
#pragma unroll
            for (int ai = 0; ai < 2; ++ai)
#pragma unroll
                for (int m = 0; m < 4; ++m) {
                    const int r = row0 + ai * HALF + m * 16; bf16_t* rowp = dst + (size_t)r * ldc + ct + cl;
#pragma unroll
                    for (int bj = 0; bj < 2; ++bj) {
                        f32x4 v0 = acc[ai][bj][m][0], v1 = acc[ai][bj][m][1];
#pragma unroll
                        for (int j = 0; j < 4; ++j) {
                            if (kind == 0) { v0[j] = fast_silu(v0[j]); v1[j] = fast_silu(v1[j]); }
                            else if (kind == 1) { v0[j] = gelu_tanh(v0[j]); v1[j] = gelu_tanh(v1[j]); }
                            else { v0[j] = fast_sigmoid(v0[j]); v1[j] = fast_sigmoid(v1[j]); } }
                        u32x4 w; w.x = cvt_pk_bf16(v0[0], v0[1]); w.y = cvt_pk_bf16(v0[2], v0[3]); w.z = cvt_pk_bf16(v1[0], v1[1]); w.w = cvt_pk_bf16(v1[2], v1[3]);
                        *(u32x4*)(rowp + bj * HALF) = w; }
                }
        }
    }
};

struct EpiSwiGLU {
    static constexpr bool PERM = true, AFTER_DRAIN = false;
    bf16_t* O; int ldc;
    __device__ __forceinline__ void operator()(const f32x4 (&acc)[2][2][4][2], const Unit& u, int wr, int wc, int fr, int fq) const {
        const int row0 = u.pm * BM + wr * 64 + fr, col0 = u.pn * HALF + wc * 32 + 8 * fq;
#pragma unroll
        for (int ai = 0; ai < 2; ++ai)
#pragma unroll
            for (int m = 0; m < 4; ++m) {
                const f32x4 g0 = acc[ai][0][m][0], g1 = acc[ai][0][m][1], u0 = acc[ai][1][m][0], u1 = acc[ai][1][m][1]; f32x4 v0, v1;
#pragma unroll
                for (int j = 0; j < 4; ++j) { v0[j] = fast_silu(g0[j]) * u0[j]; v1[j] = fast_silu(g1[j]) * u1[j]; }
                u32x4 w; w.x = cvt_pk_bf16(v0[0], v0[1]); w.y = cvt_pk_bf16(v0[2], v0[3]); w.z = cvt_pk_bf16(v1[0], v1[1]); w.w = cvt_pk_bf16(v1[2], v1[3]);
                *(u32x4*)(O + (size_t)(row0 + ai * HALF + m * 16) * ldc + col0) = w; }
    }
};

template <int MODE> struct EpiMix {
    static constexpr bool PERM = false, AFTER_DRAIN = false;
    const bf16_t* gate; float* T; bf16_t* O; int ldc;
    __device__ __forceinline__ void operator()(const f32x4 (&acc)[2][2][4][2], const Unit& u, int wr, int wc, int fr, int fq) const {
        const int row0 = u.pm * BM + wr * 64 + fr, col0 = u.pn * BM + wc * 32 + 4 * fq;
#pragma unroll
        for (int ai = 0; ai < 2; ++ai)
#pragma unroll
            for (int m = 0; m < 4; ++m) { const size_t off = (size_t)(row0 + ai * HALF + m * 16) * ldc + col0;
#pragma unroll
                for (int bj = 0; bj < 2; ++bj)
#pragma unroll
                    for (int n = 0; n < 2; ++n) { const size_t o = off + bj * HALF + n * 16;
                        const u32x2 gw = *(const u32x2*)(gate + o); const f32x4 gv = (f32x4){bf_lo(gw.x), bf_hi(gw.x), bf_lo(gw.y), bf_hi(gw.y)};
                        if (MODE == 0) { *(f32x4*)(T + o) = gv * acc[ai][bj][m][n]; }
                        else { const f32x4 v = *(const f32x4*)(T + o) + gv * acc[ai][bj][m][n]; u32x2 w; w.x = cvt_pk_bf16(v[0], v[1]); w.y = cvt_pk_bf16(v[2], v[3]); *(u32x2*)(O + o) = w; } } }
    }
};

template <bool RES_BF16> struct EpiRes {
    static constexpr bool PERM = true, AFTER_DRAIN = false;
    const void* res; bf16_t* P; int ldc; const float* ga; const float* gb; int ga_stride; int rows_per_batch; float alpha;
    __device__ __forceinline__ void operator()(const f32x4 (&acc)[2][2][4][2], const Unit& u, int wr, int wc, int fr, int fq) const {
        const int row0 = u.pm * BM + wr * 64 + fr, col0 = u.pn * BM + wc * 32 + 8 * fq; const int b = (u.pm * BM) / rows_per_batch;
        f32x4 gv[2][2];
#pragma unroll
        for (int bj = 0; bj < 2; ++bj)
#pragma unroll
            for (int n = 0; n < 2; ++n) gv[bj][n] = *(const f32x4*)(ga + (size_t)b * ga_stride + col0 + bj * HALF + n * 4) + *(const f32x4*)(gb + col0 + bj * HALF + n * 4) + 1.0f;
#pragma unroll
        for (int ai = 0; ai < 2; ++ai)
#pragma unroll
            for (int m = 0; m < 4; ++m) { const size_t off = (size_t)(row0 + ai * HALF + m * 16) * ldc + col0;
#pragma unroll
                for (int bj = 0; bj < 2; ++bj) { const size_t o = off + bj * HALF;
                    f32x4 r0, r1;
                    if (RES_BF16) { const u32x4 rw = *(const u32x4*)((const bf16_t*)res + o); r0 = (f32x4){bf_lo(rw.x), bf_hi(rw.x), bf_lo(rw.y), bf_hi(rw.y)}; r1 = (f32x4){bf_lo(rw.z), bf_hi(rw.z), bf_lo(rw.w), bf_hi(rw.w)}; }
                    else { r0 = *(const f32x4*)((const float*)res + o); r1 = *(const f32x4*)((const float*)res + o + 4); }
                    const f32x4 v0 = r0 * alpha + gv[bj][0] * acc[ai][bj][m][0], v1 = r1 * alpha + gv[bj][1] * acc[ai][bj][m][1];
                    u32x4 w; w.x = cvt_pk_bf16(v0[0], v0[1]); w.y = cvt_pk_bf16(v0[2], v0[3]); w.z = cvt_pk_bf16(v1[0], v1[1]); w.w = cvt_pk_bf16(v1[2], v1[3]);
                    *(u32x4*)(P + o) = w; } }
    }
};

struct EpiNull {
    static constexpr bool PERM = true, AFTER_DRAIN = false;
    float* sink;
    __device__ __forceinline__ void operator()(const f32x4 (&acc)[2][2][4][2], const Unit& u, int wr, int wc, int fr, int fq) const {
        float s = 0.f;
#pragma unroll
        for (int ai = 0; ai < 2; ++ai)
#pragma unroll
            for (int bj = 0; bj < 2; ++bj)
#pragma unroll
                for (int m = 0; m < 4; ++m)
#pragma unroll
                    for (int n = 0; n < 2; ++n) s += (acc[ai][bj][m][n][0] + acc[ai][bj][m][n][1]) + (acc[ai][bj][m][n][2] + acc[ai][bj][m][n][3]);
        if (s == 123456.789f) sink[0] = s;
    }
};
template <class Epi, class Sched, bool ALIGN_EPI = false, bool SP2 = false>
__device__ __forceinline__ void gemm_phase(PG8_LAS unsigned char* lds, const Gemm g, const Sched& S, const Epi& E) {
    int tid = threadIdx.x; asm volatile("" : "+v"(tid));
    const int wid = __builtin_amdgcn_readfirstlane(tid >> 6), lane = tid & 63, wr = wid >> 2, wc = wid & 3, fr = lane & 15, fq = lane >> 4;
    const int K = g.K, nt = K / BK;
    unsigned voffA[2], voffB[2];
#pragma unroll
    for (int i = 0; i < 2; ++i) { int R, C; stage_rc(tid * 16 + i * 8192, R, C); const int Rb = Epi::PERM ? ((R & ~31) + perm32(R & 31)) : R;
        voffA[i] = (unsigned)(R * K + C) * 2u; voffB[i] = (unsigned)(Rb * K + C) * 2u; }
    const size_t kstep = (size_t)(BK * 2);
    const size_t hstep = (size_t)HALF * K * 2;
    const size_t tstep = 2 * hstep;
    const unsigned ldsw = (unsigned)wid * 1024u;
    const int aoff = lds_byte(wr * 64 + fr, fq * 8), boff = lds_byte(wc * 32 + fr, fq * 8);
#define PG8_SA(b, h) (((b) * 2 + (h)) * HTB)
#define PG8_SB(b, h) ((4 + (b) * 2 + (h)) * HTB)
#define PG8_STAGE(bufoff, gbase, voff) do { _Pragma("unroll") for (int _i = 0; _i < 2; ++_i) \
        __builtin_amdgcn_global_load_lds((const unsigned*)((const char*)(gbase) + (voff)[_i]), (PG8_LAS unsigned*)(lds + (bufoff) + ldsw + _i * 8192), 16, 0, 0); } while (0)
#define PG8_LDA(dst, b, h) do { _Pragma("unroll") for (int m = 0; m < 4; ++m) _Pragma("unroll") for (int k = 0; k < 2; ++k) dst[m][k] = *(const PG8_LAS bf16x8*)(lds + PG8_SA(b, h) + aoff + m * 2048 + k * 1024); } while (0)
#define PG8_LDB(dst, b, h) do { _Pragma("unroll") for (int n = 0; n < 2; ++n) _Pragma("unroll") for (int k = 0; k < 2; ++k) dst[n][k] = *(const PG8_LAS bf16x8*)(lds + PG8_SB(b, h) + boff + n * 2048 + k * 1024); } while (0)
#define PG8_MMA(ai, bj, At, Bt) do { __builtin_amdgcn_s_setprio(1); _Pragma("unroll") for (int m = 0; m < 4; ++m) _Pragma("unroll") for (int n = 0; n < 2; ++n) _Pragma("unroll") for (int k = 0; k < 2; ++k) \
        acc[ai][bj][m][n] = __builtin_amdgcn_mfma_f32_16x16x32_bf16(Bt[n][k], At[m][k], acc[ai][bj][m][n], 0, 0, 0); __builtin_amdgcn_s_setprio(0); } while (0)
#define PG8_WAIT_V(n) asm volatile("s_waitcnt vmcnt(" #n ")" ::: "memory")
#define PG8_WAIT_L(n) asm volatile("s_waitcnt lgkmcnt(" #n ")" ::: "memory")
#define PG8_BAR __builtin_amdgcn_s_barrier()
#define PG8_SCHED __builtin_amdgcn_sched_barrier(0)
    Unit cur, nxt; int ui = 0;
    if (!S.next(0, cur)) return;
    f32x4 acc[2][2][4][2];
#pragma unroll
    for (int a = 0; a < 2; ++a)
#pragma unroll
        for (int b = 0; b < 2; ++b)
#pragma unroll
            for (int m = 0; m < 4; ++m)
#pragma unroll
                for (int n = 0; n < 2; ++n) acc[a][b][m][n] = (f32x4){0.f, 0.f, 0.f, 0.f};
    bf16x8 At[4][2], B0[2][2], B1[2][2];
    const char* cA = (const char*)g.A + (size_t)cur.pm * tstep; const char* cB = (const char*)g.Bt + (size_t)cur.pn * tstep;
    S.a_ready(cur);
    if constexpr (SP2) {
        PG8_STAGE(PG8_SB(0, 0), cB, voffB); PG8_STAGE(PG8_SB(0, 1), cB + hstep, voffB); PG8_STAGE(PG8_SA(0, 0), cA, voffA); PG8_STAGE(PG8_SA(0, 1), cA + hstep, voffA);
        if (wr == 1) PG8_BAR;
        PG8_WAIT_V(2); PG8_BAR;
        PG8_STAGE(PG8_SB(1, 0), cB + kstep, voffB); PG8_STAGE(PG8_SA(1, 0), cA + kstep, voffA); PG8_STAGE(PG8_SB(1, 1), cB + hstep + kstep, voffB);
        PG8_WAIT_V(6); PG8_BAR;
    } else {
        PG8_STAGE(PG8_SB(0, 0), cB, voffB); PG8_STAGE(PG8_SA(0, 0), cA, voffA); PG8_STAGE(PG8_SB(0, 1), cB + hstep, voffB); PG8_STAGE(PG8_SA(0, 1), cA + hstep, voffA);
        if (wr == 1) PG8_BAR;
        PG8_WAIT_V(4); PG8_BAR;
        PG8_STAGE(PG8_SB(1, 0), cB + kstep, voffB); PG8_STAGE(PG8_SA(1, 0), cA + kstep, voffA); PG8_STAGE(PG8_SB(1, 1), cB + hstep + kstep, voffB);
        PG8_WAIT_V(6); PG8_BAR;
    }
#ifdef GP_STAMP
    unsigned long long gp_tk = 0, gp_te = 0, gp_tf = 0, gp_ts = __builtin_amdgcn_s_memrealtime(), gp_tm = 0;
#endif
    for (;;) {
        const bool has_next = S.next(ui + 1, nxt);
        const char* nA = has_next ? (const char*)g.A + (size_t)nxt.pm * tstep : cA; const char* nB = has_next ? (const char*)g.Bt + (size_t)nxt.pn * tstep : cB;
        for (int t = 0; t < nt; t += 2) {
#ifdef GP_STAMP
            if (t == 4) gp_tf += __builtin_amdgcn_s_memrealtime() - gp_ts;
#endif
            const bool last = (t == nt - 2);
            const char* a1 = cA + (size_t)(t + 1) * kstep;
            const char* a2 = last ? nA : cA + (size_t)(t + 2) * kstep; const char* b2 = last ? nB : cB + (size_t)(t + 2) * kstep;
            const char* a3 = a2 + kstep; const char* b3 = b2 + kstep;
            if (last && has_next) S.a_ready(nxt);
            if constexpr (SP2) {
            PG8_LDB(B0, 0, 0); PG8_LDB(B1, 0, 1); PG8_SCHED; PG8_LDA(At, 0, 0); PG8_STAGE(PG8_SA(1, 1), a1 + hstep, voffA);
            PG8_WAIT_V(8); PG8_WAIT_L(0); PG8_BAR; PG8_MMA(0, 0, At, B0); PG8_MMA(0, 1, At, B1); PG8_BAR; PG8_SCHED;
            PG8_LDA(At, 0, 1); PG8_STAGE(PG8_SB(0, 0), b2, voffB); PG8_STAGE(PG8_SB(0, 1), b2 + hstep, voffB); PG8_STAGE(PG8_SA(0, 0), a2, voffA);
            PG8_WAIT_V(8); PG8_WAIT_L(0); PG8_BAR; PG8_MMA(1, 0, At, B0); PG8_MMA(1, 1, At, B1); PG8_BAR; PG8_SCHED;
            PG8_LDB(B0, 1, 0); PG8_LDB(B1, 1, 1); PG8_SCHED; PG8_LDA(At, 1, 0); PG8_STAGE(PG8_SA(0, 1), a2 + hstep, voffA);
            PG8_WAIT_V(8); PG8_WAIT_L(0); PG8_BAR; PG8_MMA(0, 0, At, B0); PG8_MMA(0, 1, At, B1); PG8_BAR; PG8_SCHED;
            PG8_LDA(At, 1, 1); PG8_STAGE(PG8_SB(1, 0), b3, voffB); PG8_STAGE(PG8_SB(1, 1), b3 + hstep, voffB); PG8_STAGE(PG8_SA(1, 0), a3, voffA);
            PG8_WAIT_V(8); PG8_WAIT_L(0); PG8_BAR; PG8_MMA(1, 0, At, B0); PG8_MMA(1, 1, At, B1); PG8_BAR; PG8_SCHED;
            } else {
            PG8_LDB(B0, 0, 0); PG8_SCHED; PG8_LDA(At, 0, 0); PG8_STAGE(PG8_SA(1, 1), a1 + hstep, voffA);
            PG8_WAIT_L(8); PG8_BAR; PG8_WAIT_L(0); PG8_MMA(0, 0, At, B0); PG8_BAR; PG8_SCHED;
            PG8_LDB(B1, 0, 1); PG8_STAGE(PG8_SB(0, 0), b2, voffB);
            PG8_BAR; PG8_WAIT_L(0); PG8_MMA(0, 1, At, B1); PG8_BAR;
            PG8_LDA(At, 0, 1); PG8_STAGE(PG8_SA(0, 0), a2, voffA);
            PG8_BAR; PG8_WAIT_L(0); PG8_MMA(1, 0, At, B0); PG8_BAR; PG8_SCHED;
            PG8_STAGE(PG8_SB(0, 1), b2 + hstep, voffB);
            PG8_WAIT_V(6); PG8_BAR; PG8_MMA(1, 1, At, B1); PG8_BAR;
            PG8_LDB(B0, 1, 0); PG8_SCHED; PG8_LDA(At, 1, 0); PG8_STAGE(PG8_SA(0, 1), a2 + hstep, voffA);
            PG8_WAIT_L(8); PG8_BAR; PG8_WAIT_L(0); PG8_MMA(0, 0, At, B0); PG8_BAR; PG8_SCHED;
            PG8_LDB(B1, 1, 1); PG8_STAGE(PG8_SB(1, 0), b3, voffB);
            PG8_BAR; PG8_WAIT_L(0); PG8_MMA(0, 1, At, B1); PG8_BAR;
            PG8_LDA(At, 1, 1); PG8_STAGE(PG8_SA(1, 0), a3, voffA);
            PG8_BAR; PG8_WAIT_L(0); PG8_MMA(1, 0, At, B0); PG8_BAR; PG8_SCHED;
            PG8_STAGE(PG8_SB(1, 1), b3 + hstep, voffB);
            PG8_WAIT_V(6); PG8_BAR; PG8_MMA(1, 1, At, B1); PG8_BAR;
            }
        }
#ifdef GP_STAMP
        gp_tm = __builtin_amdgcn_s_memrealtime(); gp_tk += gp_tm - gp_ts;
#endif
        if constexpr (ALIGN_EPI) { if (wr == 0) PG8_BAR; }
        if constexpr (!Epi::AFTER_DRAIN) { E(acc, cur, wr, wc, fr, fq); S.done(cur); }
        if (!has_next) break;
#pragma unroll
        for (int a = 0; a < 2; ++a)
#pragma unroll
            for (int b = 0; b < 2; ++b)
#pragma unroll
                for (int m = 0; m < 4; ++m)
#pragma unroll
                    for (int n = 0; n < 2; ++n) acc[a][b][m][n] = (f32x4){0.f, 0.f, 0.f, 0.f};
        cur = nxt; cA = nA; cB = nB; ++ui;
        if constexpr (ALIGN_EPI) { if (wr == 1) PG8_BAR; }
#ifdef GP_STAMP
        gp_ts = __builtin_amdgcn_s_memrealtime(); gp_te += gp_ts - gp_tm;
#endif
    }
#ifdef GP_STAMP
    if (S.prb && blockIdx.x == 0 && threadIdx.x == 0) { S.prb[0] += gp_tk; S.prb[1] += gp_te + (__builtin_amdgcn_s_memrealtime() - gp_tm); S.prb[2] += gp_tf; }
#endif
    PG8_WAIT_V(0);
    if constexpr (!ALIGN_EPI) { if (wr == 0) PG8_BAR; }
    PG8_BAR;
    if constexpr (Epi::AFTER_DRAIN) { E.fused(acc, cur, wr, wc, fr, fq, lds, wid, lane); S.done(cur); }
#undef PG8_SA
#undef PG8_SB
#undef PG8_STAGE
#undef PG8_LDA
#undef PG8_LDB
#undef PG8_MMA
#undef PG8_WAIT_V
#undef PG8_WAIT_L
#undef PG8_BAR
#undef PG8_SCHED
}
}
#define GAS __attribute__((address_space(1)))
#define LAS __attribute__((address_space(3)))
typedef unsigned short bf16;
typedef unsigned v4u __attribute__((ext_vector_type(4)));
typedef float f32x4 __attribute__((ext_vector_type(4)));
typedef short bf16x8 __attribute__((ext_vector_type(8)));
typedef GAS unsigned gu32;
typedef GAS unsigned long long gu64;
#define RLX_AGENT __ATOMIC_RELAXED, __HIP_MEMORY_SCOPE_AGENT
#define LDS_WAIT() asm volatile("s_waitcnt lgkmcnt(0)" ::: "memory")
#define VM_WAIT() asm volatile("s_waitcnt vmcnt(0)" ::: "memory")
__device__ __forceinline__ unsigned long long rt() { return __builtin_amdgcn_s_memrealtime(); }
__device__ __forceinline__ unsigned f2bf(float f) { unsigned u = __builtin_bit_cast(unsigned, f); return (u + 0x7fffu + ((u >> 16) & 1u)) >> 16; }
__device__ __forceinline__ unsigned pk2(float lo, float hi) { return f2bf(lo) | (f2bf(hi) << 16); }
#define XB_TMO      128
#define XB_XCNT(j)  (256  + 64 * (j))
#define XB_XSUB(j)  (1280 + 64 * (j))
#define XB_XGEN(j)  (2304 + 64 * (j))
#define XB_TOP      3328
#define XB_TOPGEN   3392
#define XCD_BAR_WORDS 3456
#define XB_SPIN_CAP (1u << 18)

__device__ __forceinline__ unsigned xb_ld(unsigned* p)              { return __hip_atomic_load(p, __ATOMIC_RELAXED, __HIP_MEMORY_SCOPE_AGENT); }
__device__ __forceinline__ unsigned xb_add(unsigned* p, unsigned v) { return __hip_atomic_fetch_add(p, v, __ATOMIC_RELAXED, __HIP_MEMORY_SCOPE_AGENT); }
__device__ __forceinline__ unsigned xb_xcc_id() { return (unsigned)__builtin_amdgcn_s_getreg((3 << 11) | 20) & 0xFu; }
#define XB_SPIN(cond, bar) do { unsigned _sp = 0; while (cond) { __builtin_amdgcn_s_sleep(1); \
    if ((++_sp & 255u) == 0u) { if (xb_ld(&(bar)[XB_TMO])) break; if (_sp > XB_SPIN_CAP) { atomicAdd(&(bar)[XB_TMO], 1u); break; } } } } while (0)

struct XcdBarrier {
    unsigned* bar; unsigned x;
    volatile LAS unsigned* st;
};

__device__ __forceinline__ XcdBarrier xcd_barrier_post(unsigned* bar, volatile LAS unsigned* st) {
    XcdBarrier b; b.bar = bar; b.x = xb_xcc_id(); b.st = st;
    if (threadIdx.x == 0) (void)xb_add(&bar[XB_XCNT(b.x)], 1u);
    return b;
}
__device__ __forceinline__ void xcd_barrier_complete(unsigned* bar, unsigned x, unsigned& nloc, unsigned& nx) {
    const unsigned G = gridDim.x * gridDim.y * gridDim.z;
    unsigned sum, cnt, mine, sp = 0u;
    for (;;) {
        sum = 0u; cnt = 0u; mine = 0u;
#pragma unroll
        for (unsigned j = 0; j < 16; ++j) { const unsigned c = xb_ld(&bar[XB_XCNT(j)]); sum += c; cnt += (c > 0u) ? 1u : 0u; mine = (j == x) ? c : mine; }
        if (sum == G) break;
        __builtin_amdgcn_s_sleep(1);
        if ((++sp & 255u) == 0u) { if (xb_ld(&bar[XB_TMO])) break; if (sp > XB_SPIN_CAP) { atomicAdd(&bar[XB_TMO], 1u); break; } }
    }
    nloc = mine > 0u ? mine : 1u; nx = cnt > 0u ? cnt : 1u;
}

__device__ __forceinline__ void xcd_barrier(const XcdBarrier& b) {
    asm volatile("s_waitcnt vmcnt(0)" ::: "memory");
    __syncthreads();
    if (threadIdx.x == 0) {
        unsigned* bar = b.bar;
        __builtin_amdgcn_s_waitcnt(0);
        unsigned nloc = b.st[0], nx = b.st[1];
        if (nloc == 0u) { xcd_barrier_complete(bar, b.x, nloc, nx); b.st[0] = nloc; b.st[1] = nx; }
        const unsigned old = xb_add(&bar[XB_XSUB(b.x)], 1u);
        const unsigned gen = old / nloc;
        if (old + 1u == (gen + 1u) * nloc) {
            __builtin_amdgcn_fence(__ATOMIC_RELEASE, "agent");
            asm volatile("s_waitcnt vmcnt(0)" ::: "memory");
            const unsigned og = xb_add(&bar[XB_TOP], 1u);
            const unsigned tg = og / nx;
            if (og + 1u == (tg + 1u) * nx) xb_add(&bar[XB_TOPGEN], 1u);
            else XB_SPIN(xb_ld(&bar[XB_TOPGEN]) == tg, bar);
            __builtin_amdgcn_fence(__ATOMIC_ACQUIRE, "agent");
            xb_add(&bar[XB_XGEN(b.x)], 1u);
            asm volatile("s_waitcnt vmcnt(0)" ::: "memory");
        } else {
            XB_SPIN(xb_ld(&bar[XB_XGEN(b.x)]) == gen, bar);
            __builtin_amdgcn_fence(__ATOMIC_ACQUIRE, "agent");
            asm volatile("s_waitcnt vmcnt(0)" ::: "memory");
        }
    }
    __syncthreads();
}

typedef unsigned u32x2 __attribute__((ext_vector_type(2)));
typedef float f32x2 __attribute__((ext_vector_type(2)));
#define MFMA16(a, b, c) __builtin_amdgcn_mfma_f32_16x16x32_bf16((a), (b), (c), 0, 0, 0)
__device__ __forceinline__ float wave_sum(float v) {
#pragma unroll
    for (int o = 1; o < 64; o <<= 1) v += __shfl_xor(v, o);
    return v;
}
__device__ __forceinline__ float bflo(unsigned w) { return __uint_as_float(w << 16); }
__device__ __forceinline__ float bfhi(unsigned w) { return __uint_as_float(w & 0xffff0000u); }
__device__ __forceinline__ unsigned pkbf(float lo, float hi) { return pg8::cvt_pk_bf16(lo, hi); }

struct Args { const float* in[19]; float* out; unsigned char* ws; int ph_lo, ph_hi; };

__device__ __forceinline__ void p0_transpose_item(const float* W, int K, int N, bf16* WT, int kb, int n0, int row0, int lane) {
    const GAS float* src = (const GAS float*)W + (size_t)(kb * 64) * N + n0 + lane;
    float v[64];
#pragma unroll
    for (int i = 0; i < 64; ++i) v[i] = src[(size_t)i * N];
    GAS v4u* dst = (GAS v4u*)((GAS bf16*)WT + (size_t)(row0 + lane) * K + kb * 64);
#pragma unroll
    for (int c = 0; c < 8; ++c) { v4u o; o.x = pkbf(v[8 * c], v[8 * c + 1]); o.y = pkbf(v[8 * c + 2], v[8 * c + 3]); o.z = pkbf(v[8 * c + 4], v[8 * c + 5]); o.w = pkbf(v[8 * c + 6], v[8 * c + 7]); dst[c] = o; }
}
__device__ __forceinline__ int gu_row0(int n0) {
    const int up = n0 >= DFF ? 1 : 0, j = n0 - up * DFF; return 256 * (j >> 7) + 128 * up + (j & 127);
}

template <int MODE> __device__ __forceinline__ void row_pass(int gw, int NGW, int lane, const void* src, const float* lg, const float* lb, float* Yf, bf16* Yb, bf16* H,
                                                             const float* ada, const float* bada, int seg_sh, int seg_sc) {
#define RP_F4(base, boff) (*(const GAS f32x4*)((const GAS char*)(base) + (boff)))
#define RP_U4(base, boff) (*(const GAS v4u*)((const GAS char*)(base) + (boff)))
    for (int row = gw; row < M; row += NGW) {
        const int b = row / SEQ;
        unsigned l16; asm volatile("v_lshlrev_b32 %0, 4, %1" : "=v"(l16) : "v"(lane));
        const unsigned l32 = 2u * l16;
        f32x4 v[8][2];
        if (MODE == 0) {
            const float* sp = (const float*)src + (size_t)row * D;
#pragma unroll
            for (int j = 0; j < 8; ++j) { v[j][0] = RP_F4(sp, 2048u * j + l32); v[j][1] = RP_F4(sp, 2048u * j + 16u + l32); }
        } else {
            const bf16* sp = (const bf16*)src + (size_t)row * D;
#pragma unroll
            for (int j = 0; j < 8; ++j) { const v4u w = RP_U4(sp, 1024u * j + l16); v[j][0] = (f32x4){bflo(w.x), bfhi(w.x), bflo(w.y), bfhi(w.y)}; v[j][1] = (f32x4){bflo(w.z), bfhi(w.z), bflo(w.w), bfhi(w.w)}; }
            float s = 0.f;
#pragma unroll
            for (int j = 0; j < 8; ++j) s += ((v[j][0].x + v[j][0].y) + (v[j][0].z + v[j][0].w)) + ((v[j][1].x + v[j][1].y) + (v[j][1].z + v[j][1].w));
            const float mean = wave_sum(s) * (1.f / D); float s2 = 0.f;
#pragma unroll
            for (int j = 0; j < 8; ++j)
#pragma unroll
                for (int q = 0; q < 2; ++q) { v[j][q] = v[j][q] - mean; s2 += (v[j][q].x * v[j][q].x + v[j][q].y * v[j][q].y) + (v[j][q].z * v[j][q].z + v[j][q].w * v[j][q].w); }
            const float rstd = 1.0f / sqrtf(wave_sum(s2) * (1.f / D) + LN_EPS);
            const float* ash = ada + (size_t)b * ADAW + seg_sh * D; const float* bsh = bada + seg_sh * D;
            const float* asc = ada + (size_t)b * ADAW + seg_sc * D; const float* bsc = bada + seg_sc * D;
            float* ypf = Yf + (size_t)row * D; bf16* ypb = Yb + (size_t)row * D; bf16* hp = H + (size_t)row * D;
#pragma unroll
            for (int j = 0; j < 8; ++j) {
                f32x4 y[2];
#pragma unroll
                for (int q = 0; q < 2; ++q) { const unsigned bo = 2048u * j + 16u * q + l32; y[q] = v[j][q] * rstd * RP_F4(lg, bo) + RP_F4(lb, bo); }
                if (MODE == 2) { *(GAS f32x4*)((GAS char*)ypf + (2048u * j + l32)) = y[0]; *(GAS f32x4*)((GAS char*)ypf + (2048u * j + 16u + l32)) = y[1]; }
                else {
                    v4u w; w.x = pkbf(y[0].x, y[0].y); w.y = pkbf(y[0].z, y[0].w); w.z = pkbf(y[1].x, y[1].y); w.w = pkbf(y[1].z, y[1].w); *(GAS v4u*)((GAS char*)ypb + (1024u * j + l16)) = w;
                    f32x4 o[2];
#pragma unroll
                    for (int q = 0; q < 2; ++q) { const unsigned bo = 2048u * j + 16u * q + l32; const f32x4 sh = RP_F4(ash, bo) + RP_F4(bsh, bo), sc = RP_F4(asc, bo) + RP_F4(bsc, bo) + 1.0f; o[q] = y[q] * sc + sh; }
                    v4u h; h.x = pkbf(o[0].x, o[0].y); h.y = pkbf(o[0].z, o[0].w); h.z = pkbf(o[1].x, o[1].y); h.w = pkbf(o[1].z, o[1].w); *(GAS v4u*)((GAS char*)hp + (1024u * j + l16)) = h;
                }
                if (j & 1) asm volatile("" ::: "memory");
            }
        }
        if (MODE == 0) {
            const float* ash = ada + (size_t)b * ADAW + seg_sh * D; const float* bsh = bada + seg_sh * D;
            const float* asc = ada + (size_t)b * ADAW + seg_sc * D; const float* bsc = bada + seg_sc * D;
            bf16* hp = H + (size_t)row * D;
#pragma unroll
            for (int j = 0; j < 8; ++j) { f32x4 o[2];
#pragma unroll
                for (int q = 0; q < 2; ++q) { const unsigned bo = 2048u * j + 16u * q + l32; const f32x4 sh = RP_F4(ash, bo) + RP_F4(bsh, bo), sc = RP_F4(asc, bo) + RP_F4(bsc, bo) + 1.0f; o[q] = v[j][q] * sc + sh; }
                v4u w; w.x = pkbf(o[0].x, o[0].y); w.y = pkbf(o[0].z, o[0].w); w.z = pkbf(o[1].x, o[1].y); w.w = pkbf(o[1].z, o[1].w); *(GAS v4u*)((GAS char*)hp + (1024u * j + l16)) = w; if ((j & 3) == 3) asm volatile("" ::: "memory"); }
        }
    }
#undef RP_F4
#undef RP_U4
}

__device__ __forceinline__ void ret_state_unit(int lane, int wave, int bh, int eb, int db, const bf16* KT, const bf16* VT, bf16* RG) {
    const int h = bh & 7, i = lane & 15, g = lane >> 4;
    const int et = eb * 4 + (wave >> 1), dt0 = db * 4 + 2 * (wave & 1);
    const float l2g = pg8::log2_gamma(h);
    const float gam = __builtin_amdgcn_exp2f(l2g), g127 = __builtin_amdgcn_exp2f(127.0f * l2g), g128 = __builtin_amdgcn_exp2f(128.0f * l2g);
    const GAS bf16* KTp = (const GAS bf16*)KT + (size_t)bh * 32 * 32768 + (dt0 * 4) * 512 + lane * 8;
    const GAS bf16* VTp = (const GAS bf16*)VT + (size_t)bh * 32 * 32768 + (et * 4) * 512 + lane * 8;
    GAS bf16* Rp = (GAS bf16*)RG + (size_t)bh * 32 * 65536;
    int roff[2];
#pragma unroll
    for (int t = 0; t < 2; ++t) roff[t] = pg8::frag_off(16 * et + i, 16 * (dt0 + t) + 4 * g, 8);
    f32x4 st[2]; st[0] = (f32x4){0.f, 0.f, 0.f, 0.f}; st[1] = st[0];
    bf16x8 vf[3][4], kt[3][2][4];
#define RS_LOAD(cc, sl) do { const int tn_ = ((cc) < SEQ / CHK ? (cc) : SEQ / CHK - 1) * 32768; \
        _Pragma("unroll") for (int s = 0; s < 4; ++s) vf[sl][s] = *(const GAS bf16x8*)(VTp + tn_ + s * 512); \
        _Pragma("unroll") for (int t = 0; t < 2; ++t) _Pragma("unroll") for (int s = 0; s < 4; ++s) kt[sl][t][s] = *(const GAS bf16x8*)(KTp + tn_ + (t * 4 + s) * 512); } while (0)
    RS_LOAD(0, 0); RS_LOAD(1, 1);
    for (int c3 = 0; c3 < SEQ / CHK; c3 += 3) {
#pragma unroll
        for (int u = 0; u < 3; ++u) {
            const int c = c3 + u;
            if (c >= SEQ / CHK) break;
            RS_LOAD(c + 2, (u + 2) % 3);
#pragma unroll
            for (int t = 0; t < 2; ++t) {
                u32x2 w; w.x = pkbf(gam * st[t][0], gam * st[t][1]); w.y = pkbf(gam * st[t][2], gam * st[t][3]);
                *(GAS u32x2*)(Rp + (size_t)c * 65536 + roff[t]) = w;
                f32x4 tmp = (f32x4){0.f, 0.f, 0.f, 0.f};
#pragma unroll
                for (int s = 0; s < 4; ++s) tmp = MFMA16(kt[u][t][s], vf[u][s], tmp);
                st[t] = st[t] * g128 + tmp * g127;
            }
        }
    }
#undef RS_LOAD
}
__device__ __forceinline__ void ret_out_unit(LAS unsigned char* lds, int tid, int lane, int wave, int bh, int c, const bf16* Q, const bf16* K, const bf16* VT, const bf16* RG, const bf16* GS, bf16* RETG) {
    constexpr int KQ_OFF = 0, KQ_PITCH = 528, PL_OFF = 128 * KQ_PITCH, PL_PITCH = 272, ST_OFF = PL_OFF + 128 * PL_PITCH;
    static_assert(ST_OFF + 128 * 8 * 8 <= RING_BYTES, "retention LDS");
    const int b = bh >> 3, h = bh & 7, i = lane & 15, g = lane >> 4, rb = wave, tok0 = b * SEQ + c * CHK;
    const GAS bf16* Qp = (const GAS bf16*)Q + (size_t)tok0 * RW + 256 * h;
    const GAS bf16* Kp = (const GAS bf16*)K + (size_t)tok0 * RW + 256 * h;
    v4u kreg[8];
#pragma unroll
    for (int q = 0; q < 8; ++q) { const int idx = tid + 512 * q, row = idx >> 5, c16 = idx & 31; kreg[q] = *(const GAS v4u*)(Kp + (size_t)row * RW + c16 * 8); }
    bf16x8 qf[8];
#pragma unroll
    for (int s = 0; s < 8; ++s) qf[s] = *(const GAS bf16x8*)(Qp + (size_t)(16 * rb + i) * RW + 32 * s + 8 * g);
#pragma unroll
    for (int q = 0; q < 8; ++q) { const int idx = tid + 512 * q, row = idx >> 5, c16 = idx & 31; *(LAS v4u*)(lds + KQ_OFF + row * KQ_PITCH + c16 * 16) = kreg[q]; }
    __syncthreads();
#pragma unroll
    for (int q = 0; q < 8; ++q) { const int idx = tid + 512 * q, row = idx >> 5, c16 = idx & 31; kreg[q] = *(const GAS v4u*)(Qp + (size_t)row * RW + c16 * 8); }
    bf16x8 vf[2][4], rf[2][8];
    {
        const GAS bf16* VTp = (const GAS bf16*)VT + ((size_t)bh * 32 + c) * 32768 + (2 * wave * 4) * 512 + lane * 8;
        const GAS bf16* RGp = (const GAS bf16*)RG + ((size_t)bh * 32 + c) * 65536 + (2 * wave * 8) * 512 + lane * 8;
#pragma unroll
        for (int t = 0; t < 2; ++t) {
#pragma unroll
            for (int s = 0; s < 4; ++s) vf[t][s] = *(const GAS bf16x8*)(VTp + (t * 4 + s) * 512);
#pragma unroll
            for (int s = 0; s < 8; ++s) rf[t][s] = *(const GAS bf16x8*)(RGp + (t * 8 + s) * 512);
        }
    }
    for (int j = 0; j <= rb; ++j) {
        f32x4 acc = (f32x4){0.f, 0.f, 0.f, 0.f};
#pragma unroll
        for (int s = 0; s < 8; ++s) { const bf16x8 a = *(const LAS bf16x8*)(lds + KQ_OFF + (16 * j + i) * KQ_PITCH + (32 * s + 8 * g) * 2); acc = MFMA16(a, qf[s], acc); }
        if (j == rb) {
#pragma unroll
            for (int r = 0; r < 4; ++r) if (4 * g + r > i) acc[r] = 0.f;
        }
        u32x2 w; w.x = pkbf(acc[0], acc[1]); w.y = pkbf(acc[2], acc[3]);
        *(LAS u32x2*)(lds + PL_OFF + (16 * rb + i) * PL_PITCH + (16 * j + 4 * g) * 2) = w;
    }
    if ((rb & 1) == 0) { u32x2 z; z.x = 0u; z.y = 0u; *(LAS u32x2*)(lds + PL_OFF + (16 * rb + i) * PL_PITCH + (16 * (rb + 1) + 4 * g) * 2) = z; }
    __syncthreads();
#pragma unroll
    for (int q = 0; q < 8; ++q) { const int idx = tid + 512 * q, row = idx >> 5, c16 = idx & 31; *(LAS v4u*)(lds + KQ_OFF + row * KQ_PITCH + c16 * 16) = kreg[q]; }
    __syncthreads();
    f32x4 o[8][2];
#pragma unroll
    for (int nb = 0; nb < 8; ++nb) {
        o[nb][0] = (f32x4){0.f, 0.f, 0.f, 0.f}; o[nb][1] = o[nb][0];
#pragma unroll
        for (int s = 0; s < 4; ++s) if (s <= (nb >> 1)) {
            const bf16x8 p = *(const LAS bf16x8*)(lds + PL_OFF + (16 * nb + i) * PL_PITCH + (32 * s + 8 * g) * 2);
            o[nb][0] = MFMA16(vf[0][s], p, o[nb][0]); o[nb][1] = MFMA16(vf[1][s], p, o[nb][1]); }
#pragma unroll
        for (int s = 0; s < 8; ++s) {
            const bf16x8 qq = *(const LAS bf16x8*)(lds + KQ_OFF + (16 * nb + i) * KQ_PITCH + (32 * s + 8 * g) * 2);
            o[nb][0] = MFMA16(rf[0][s], qq, o[nb][0]); o[nb][1] = MFMA16(rf[1][s], qq, o[nb][1]); }
    }
    LAS f32x2* ST = (LAS f32x2*)(lds + ST_OFF);
#pragma unroll
    for (int nb = 0; nb < 8; ++nb) {
        float s1 = 0.f, s2 = 0.f;
#pragma unroll
        for (int t = 0; t < 2; ++t)
#pragma unroll
            for (int r = 0; r < 4; ++r) { const float v = o[nb][t][r]; s1 += v; s2 += v * v; }
        s1 += __shfl_xor(s1, 16); s1 += __shfl_xor(s1, 32); s2 += __shfl_xor(s2, 16); s2 += __shfl_xor(s2, 32);
        if (g == 0) { f32x2 v; v.x = s1; v.y = s2; ST[(16 * nb + i) * 8 + wave] = v; }
    }
    __syncthreads();
#pragma unroll
    for (int nb = 0; nb < 8; ++nb) {
        float s1 = 0.f, s2 = 0.f;
#pragma unroll
        for (int w = 0; w < 8; ++w) { const f32x2 v = ST[(16 * nb + i) * 8 + w]; s1 += v.x; s2 += v.y; }
        const float mean = s1 * (1.f / HD), var = fmaxf(s2 * (1.f / HD) - mean * mean, 0.f), rstd = 1.0f / sqrtf(var + LN_EPS);
        const size_t rowoff = (size_t)(tok0 + 16 * nb + i) * RW + 256 * h + 32 * wave + 4 * g;
#pragma unroll
        for (int t = 0; t < 2; ++t) {
            const u32x2 gwv = *(const GAS u32x2*)(GS + rowoff + 16 * t);
            const f32x4 y = (o[nb][t] - mean) * rstd * (f32x4){bflo(gwv.x), bfhi(gwv.x), bflo(gwv.y), bfhi(gwv.y)};
            u32x2 w; w.x = pkbf(y[0], y[1]); w.y = pkbf(y[2], y[3]); *(GAS u32x2*)(RETG + rowoff + 16 * t) = w;
        }
    }
    __syncthreads();
}

__device__ __forceinline__ void sg_unit(LAS unsigned char* lds, int tid, int lane, int wave, int ck, int grp, const float* sgw, const float* sgb, const float* lng, const float* lnb,
                                        const float* stats, const bf16* ST, const bf16* UG, bf16* SGU) {
    constexpr int WL_OFF = 0, WL_PITCH = 272, MU_OFF = 128 * WL_PITCH, RS_OFF = MU_OFF + 512, C1_OFF = RS_OFF + 512, C2_OFF = C1_OFF + 512, BS_OFF = C2_OFF + 512;
    const int tok0 = ck * CHK;
    LAS float* MU = (LAS float*)(lds + MU_OFF); LAS float* RS = (LAS float*)(lds + RS_OFF); LAS float* C1 = (LAS float*)(lds + C1_OFF); LAS float* C2 = (LAS float*)(lds + C2_OFF); LAS float* BS = (LAS float*)(lds + BS_OFF);
    if (tid < CHK) {
        const GAS f32x2* sp = (const GAS f32x2*)(stats + (size_t)(tok0 + tid) * 64); float s = 0.f, q = 0.f;
#pragma unroll 8
        for (int p = 0; p < 32; ++p) { const f32x2 v = sp[p]; s += v.x; q += v.y; }
        const float mean = s * (1.f / SGW), var = fmaxf(q * (1.f / SGW) - mean * mean, 0.f);
        MU[tid] = mean; RS[tid] = 1.0f / sqrtf(var + LN_EPS);
    }
    __syncthreads();
    {
        const int t = tid >> 2, sq = tid & 3; const GAS float* wrow = (const GAS float*)sgw + ((size_t)grp * CHK + t) * CHK + 32 * sq;
        float c1 = 0.f, c2 = 0.f;
#pragma unroll
        for (int j = 0; j < 32; j += 2) { const int s = 32 * sq + j; const float w0 = (s <= t) ? wrow[j] : 0.f, w1 = (s + 1 <= t) ? wrow[j + 1] : 0.f;
            const float a0 = w0 * RS[s], a1 = w1 * RS[s + 1]; c2 += w0 + w1; c1 += a0 * MU[s] + a1 * MU[s + 1];
            *(LAS unsigned*)(lds + WL_OFF + t * WL_PITCH + s * 2) = pkbf(a0, a1); }
        c1 += __shfl_xor(c1, 1); c1 += __shfl_xor(c1, 2); c2 += __shfl_xor(c2, 1); c2 += __shfl_xor(c2, 2);
        if (sq == 0) { C1[t] = c1; C2[t] = c2; BS[t] = sgb[grp * CHK + t]; }
    }
    __syncthreads();
    const int i = lane & 15, g = lane >> 4, trow = 16 * wave + i, nsteps = (wave >> 1) + 1;
    bf16x8 wf[4];
#pragma unroll
    for (int s = 0; s < 4; ++s) wf[s] = *(const LAS bf16x8*)(lds + WL_OFF + trow * WL_PITCH + (32 * s + 8 * g) * 2);
    const float c1t = C1[trow], c2t = C2[trow], bst = BS[trow];
    bf16x8 af[3][4]; f32x4 lgv[3], lbv[3]; u32x2 uwv[3];
    const GAS bf16* spb = (const GAS bf16*)ST + (size_t)ck * 262144 + (16 * grp * 4) * 512 + lane * 8;
    const int chb = GD * grp + 4 * g;
    const GAS bf16* ugp = (const GAS bf16*)UG + (size_t)(tok0 + trow) * SGW + chb;
    GAS bf16* sgp = (GAS bf16*)SGU + (size_t)(tok0 + trow) * SGW + chb;
#define SG_LOAD(j, sl) do { _Pragma("unroll") for (int s = 0; s < 4; ++s) if (s < nsteps) af[sl][s] = *(const GAS bf16x8*)(spb + ((j) * 4 + s) * 512); \
        lgv[sl] = *(const GAS f32x4*)(lng + chb + 16 * (j)); lbv[sl] = *(const GAS f32x4*)(lnb + chb + 16 * (j)); uwv[sl] = *(const GAS u32x2*)(ugp + 16 * (j)); } while (0)
    SG_LOAD(0, 0); SG_LOAD(1, 1);
#pragma unroll
    for (int j = 0; j < 16; ++j) {
        if (j + 2 < 16) SG_LOAD(j + 2, (j + 2) % 3);
        const int sl = j % 3;
        f32x4 acc = (f32x4){0.f, 0.f, 0.f, 0.f};
#pragma unroll
        for (int s = 0; s < 4; ++s) if (s < nsteps) acc = MFMA16(af[sl][s], wf[s], acc);
        const f32x4 uv = (f32x4){bflo(uwv[sl].x), bfhi(uwv[sl].x), bflo(uwv[sl].y), bfhi(uwv[sl].y)};
        const f32x4 val = uv * (lgv[sl] * (acc - c1t) + lbv[sl] * c2t + bst);
        u32x2 w; w.x = pkbf(val[0], val[1]); w.y = pkbf(val[2], val[3]);
        *(GAS u32x2*)(sgp + 16 * j) = w;
    }
#undef SG_LOAD
    __syncthreads();
}

__global__ void __launch_bounds__(NWAVES * 64, 2) fwd(Args args) {
    extern __shared__ __attribute__((aligned(16))) unsigned char lds_raw[];
    LAS unsigned char* lds = (LAS unsigned char*)lds_raw;
    volatile LAS unsigned* MISC = (volatile LAS unsigned*)(lds + MISC_OFF);
    const int tid = threadIdx.x, lane = tid & 63, wave = __builtin_amdgcn_readfirstlane(tid >> 6);
    const int G = gridDim.x, bx = blockIdx.x, vcu = (G % 8 == 0) ? (bx % 8) * (G / 8) + bx / 8 : bx;
    const int gw = vcu * NWAVES + wave, NGW = G * NWAVES;
    unsigned char* ws = args.ws;
    unsigned* ctl = (unsigned*)(ws + WS_CTL);
    const float* x = args.in[0]; const float* cin = args.in[1]; const int* pos = (const int*)args.in[2]; const float* w_ada = args.in[3]; const float* b_ada = args.in[4];
    const float* w_in = args.in[5]; const float* sg_ln_g = args.in[6]; const float* sg_ln_b = args.in[7]; const float* sg_w = args.in[8]; const float* sg_b = args.in[9];
    const float* w_ret_up = args.in[10]; const float* w_sg_up = args.in[11]; const float* w_out = args.in[12]; const float* ln1_g = args.in[13]; const float* ln1_b = args.in[14];
    const float* w_gate_up = args.in[15]; const float* w_down = args.in[16]; const float* ln2_g = args.in[17]; const float* ln2_b = args.in[18];
    float* ada = (float*)(ctl + CW_ADA);
    float* cosT = (float*)(ws + WS_COS); float* sinT = (float*)(ws + WS_SIN); float* stats = (float*)(ws + WS_STATS);
    bf16 *WIN = (bf16*)(ws + WS_WIN), *WRET = (bf16*)(ws + WS_WRET), *WSG = (bf16*)(ws + WS_WSG), *WOUT = (bf16*)(ws + WS_WOUT), *WGU = (bf16*)(ws + WS_WGU), *WDN = (bf16*)(ws + WS_WDN);
    bf16 *H = (bf16*)(ws + WS_H), *Qb = (bf16*)(ws + WS_Q), *Kb = (bf16*)(ws + WS_K), *KTb = (bf16*)(ws + WS_KT), *VTb = (bf16*)(ws + WS_VT), *GSb = (bf16*)(ws + WS_GS), *UGb = (bf16*)(ws + WS_UG), *STb = (bf16*)(ws + WS_ST);
    bf16 *SIGR = (bf16*)(ws + WS_SIGR), *SIGS = (bf16*)(ws + WS_SIGS), *RETG = (bf16*)(ws + WS_RETG), *SGU = (bf16*)(ws + WS_SGU), *MIX = (bf16*)(ws + WS_MIX), *ACT = (bf16*)(ws + WS_ACT);
    bf16* RGb = (bf16*)(ws + WS_RET);
    float* PRE = (float*)(ws + WS_PRE);
    bf16 *PREb = (bf16*)(ws + WS_X1), *X1b = (bf16*)(ws + WS_X1 + 64 * MiB);

    for (int u = tid; u < (LDS_BYTES - LDSCTL_OFF) / 4; u += NWAVES * 64) ((LAS unsigned*)(lds + LDSCTL_OFF))[u] = 0u;
    __syncthreads();
    XcdBarrier bar; bar.bar = ctl + CW_BAR; bar.x = 0; bar.st = nullptr;
    if (MK_N_LAUNCHES == 1) bar = xcd_barrier_post(ctl + CW_BAR, MISC + 8);
    const int lo = args.ph_lo, hi = args.ph_hi;
#ifdef GP_STAMP
    unsigned long long* prb = (unsigned long long*)(ctl + 32768);
    unsigned long long gp_prev = __builtin_amdgcn_s_memrealtime();
#define PSTAMP(k) do { if (bx == 0 && tid == 0) { const unsigned long long now_ = __builtin_amdgcn_s_memrealtime(); prb[64 + (k)] = now_ - gp_prev; gp_prev = now_; } } while (0)
#define SPRB(k) S.prb = prb + 4 * (k);
#else
#define PSTAMP(k) do {} while (0)
#define SPRB(k)
#endif
#ifndef PH_MASK
#ifdef DBG_STOP
#define PH_MASK (((2u << DBG_STOP) - 1u) | 0x800u)
#else
#define PH_MASK 0xfff
#endif
#endif
#define IN(k) (((PH_MASK >> (k)) & 1) && lo <= (k) && (k) < hi)
#define SEAM(k) do { if (IN(k) && IN((k) + 1)) xcd_barrier(bar); PSTAMP(k); } while (0)
#ifndef DUP_MASK
#define DUP_MASK 0
#endif
#define REP(k) for (int rep_ = 0; rep_ < (((DUP_MASK >> (k)) & 1) ? 2 : 1); ++rep_)

    if (IN(0)) REP(0) {
        LAS float* scl = (LAS float*)(lds + RING_OFF);
        for (int u = tid; u < BATCH * D; u += NWAVES * 64) { const float v = cin[u]; scl[u] = v / (1.0f + expf(-v)); }
        __syncthreads();
#ifndef DUP_P0
#define DUP_P0 0
#endif
        for (int rr0 = 0; rr0 < ((DUP_P0 & 1) ? 2 : 1); ++rr0)
        for (int cb = vcu; cb < ADAW / 96; cb += G) {
            const int half = lane / 24, c4 = lane - 24 * half;
            f32x4 a0 = (f32x4){0.f, 0.f, 0.f, 0.f}, a1 = a0;
            if (lane < 48) {
                const GAS float* wp = (const GAS float*)w_ada + (size_t)(512 * wave + half) * ADAW + cb * 96 + 4 * c4;
#pragma unroll 8
                for (int kk = 0; kk < 256; ++kk) { const f32x4 w = *(const GAS f32x4*)(wp + (size_t)(2 * kk) * ADAW); const int k = 512 * wave + 2 * kk + half; const float s0 = scl[k], s1 = scl[D + k]; a0 += w * s0; a1 += w * s1; }
            }
            LAS f32x4* red = (LAS f32x4*)(lds + RING_OFF + 32768);
            if (lane < 48) { red[(wave * 48 + lane) * 2] = a0; red[(wave * 48 + lane) * 2 + 1] = a1; }
            __syncthreads();
            if (tid < 48) {
                const int bsel = tid / 24, cc = tid - 24 * bsel; f32x4 s = (f32x4){0.f, 0.f, 0.f, 0.f};
#pragma unroll
                for (int w = 0; w < 8; ++w) { s += red[(w * 48 + cc) * 2 + bsel]; s += red[(w * 48 + 24 + cc) * 2 + bsel]; }
                *(GAS f32x4*)(ada + (size_t)bsel * ADAW + cb * 96 + 4 * cc) = s;
            }
            __syncthreads();
        }
        for (int rr1 = 0; rr1 < ((DUP_P0 & 2) ? 2 : 1); ++rr1)
        {
            constexpr int I0 = (D / 64) * (INW / 64), I1 = (RW / 64) * (D / 64), I2 = I1, I3 = (D / 64) * (D / 64), I4 = (D / 64) * (2 * DFF / 64), I5 = (DFF / 64) * (D / 64);
            constexpr int NIT = I0 + I1 + I2 + I3 + I4 + I5;
            for (int it = gw; it < NIT; it += NGW) {
                int r = it;
#ifdef TR_NFAST
#define TR_KB(r, KB, NB) ((r) / (NB))
#define TR_NB(r, KB, NB) ((r) % (NB))
#else
#define TR_KB(r, KB, NB) ((r) % (KB))
#define TR_NB(r, KB, NB) ((r) / (KB))
#endif
                if (r < I0) { const int kb = TR_KB(r, D / 64, INW / 64), n0 = TR_NB(r, D / 64, INW / 64) * 64; p0_transpose_item(w_in, D, INW, WIN, kb, n0, n0, lane); continue; } r -= I0;
                if (r < I1) { const int kb = TR_KB(r, RW / 64, D / 64), n0 = TR_NB(r, RW / 64, D / 64) * 64; p0_transpose_item(w_ret_up, RW, D, WRET, kb, n0, n0, lane); continue; } r -= I1;
                if (r < I2) { const int kb = TR_KB(r, SGW / 64, D / 64), n0 = TR_NB(r, SGW / 64, D / 64) * 64; p0_transpose_item(w_sg_up, SGW, D, WSG, kb, n0, n0, lane); continue; } r -= I2;
                if (r < I3) { const int kb = TR_KB(r, D / 64, D / 64), n0 = TR_NB(r, D / 64, D / 64) * 64; p0_transpose_item(w_out, D, D, WOUT, kb, n0, n0, lane); continue; } r -= I3;
                if (r < I4) { const int kb = TR_KB(r, D / 64, 2 * DFF / 64), n0 = TR_NB(r, D / 64, 2 * DFF / 64) * 64; p0_transpose_item(w_gate_up, D, 2 * DFF, WGU, kb, n0, gu_row0(n0), lane); continue; } r -= I4;
                { const int kb = TR_KB(r, DFF / 64, D / 64), n0 = TR_NB(r, DFF / 64, D / 64) * 64; p0_transpose_item(w_down, DFF, D, WDN, kb, n0, n0, lane); }
            }
        }
        for (int rr2 = 0; rr2 < ((DUP_P0 & 4) ? 2 : 1); ++rr2)
        for (int e = (vcu * NWAVES * 64 + tid); e < M * 128; e += G * NWAVES * 64) {
            const int row = e >> 7, j = e & 127;
            const float inv = (float)exp2(-(double)j * (13.287712379549449 / 128.0));
            const float angf = (float)pos[row] * inv;
            const double a = (double)angf; const double rr = a - 6.283185307179586476925 * rint(a * 0.15915494309189533577);
            cosT[e] = cosf((float)rr); sinT[e] = sinf((float)rr);
        }
        __syncthreads();
    }
    SEAM(0);
    if (IN(1)) REP(1) row_pass<0>(gw, NGW, lane, x, nullptr, nullptr, nullptr, nullptr, H, ada, b_ada, 0, 1);
    SEAM(1);
    if (IN(2)) REP(2) {
        pg8::Gemm g{H, WIN, M, INW, D}; pg8::StaticOrder S; S.init(M, INW, G, bx); SPRB(2)
        pg8::EpiZ E{ws, stats, cosT, sinT};
        pg8::gemm_phase<pg8::EpiZ, pg8::StaticOrder, true, true>(lds + RING_OFF, g, S, E);
    }
    SEAM(2);
    if (IN(3)) REP(3) {
#ifndef DUP_SUB
#define DUP_SUB 0
#endif
        for (int rr = 0; rr < ((DUP_SUB & 1) ? 2 : 1); ++rr)
        for (int u0 = vcu; u0 < 256; u0 += G) { const int uid = (u0 + 100 * rr) & 255; ret_state_unit(lane, wave, uid >> 4, (uid >> 2) & 3, uid & 3, KTb, VTb, RGb); }
        for (int rr = 0; rr < ((DUP_SUB & 2) ? 2 : 1); ++rr)
        for (int u0 = vcu; u0 < 512; u0 += G) { const int uid = (u0 + 200 * rr) & 511; sg_unit(lds + RING_OFF, tid, lane, wave, uid >> 3, uid & 7, sg_w, sg_b, sg_ln_g, sg_ln_b, stats, STb, UGb, SGU); }
    }
    SEAM(3);
    if (IN(4)) REP(4) {
        for (int u0 = vcu; u0 < 512; u0 += G) { const int uid = (u0 + 200 * rep_) & 511; ret_out_unit(lds + RING_OFF, tid, lane, wave, uid >> 5, uid & 31, Qb, Kb, VTb, RGb, GSb, RETG); }
    }
    SEAM(4);
    if (IN(5)) REP(5) {
        pg8::Gemm g{RETG, WRET, M, D, RW}; pg8::StaticOrder S; S.init(M, D, G, bx); SPRB(5)
        pg8::EpiMix<0> E{SIGR, PRE, nullptr, D};
        pg8::gemm_phase<pg8::EpiMix<0>, pg8::StaticOrder, true, true>(lds + RING_OFF, g, S, E);
    }
    SEAM(5);
    if (IN(6)) REP(6) {
        pg8::Gemm g{SGU, WSG, M, D, SGW}; pg8::StaticOrder S; S.init(M, D, G, bx); SPRB(6)
        pg8::EpiMix<1> E{SIGS, PRE, MIX, D};
        pg8::gemm_phase<pg8::EpiMix<1>, pg8::StaticOrder, true, true>(lds + RING_OFF, g, S, E);
    }
    SEAM(6);
    if (IN(7)) REP(7) {
        pg8::Gemm g{MIX, WOUT, M, D, D}; pg8::StaticOrder S; S.init(M, D, G, bx); SPRB(7)
        pg8::EpiRes<false> E{x, PREb, D, ada + 2 * D, b_ada + 2 * D, ADAW, SEQ, ALPHA};
        pg8::gemm_phase<pg8::EpiRes<false>, pg8::StaticOrder, true, true>(lds + RING_OFF, g, S, E);
    }
    SEAM(7);
    if (IN(8)) REP(8) row_pass<1>(gw, NGW, lane, PREb, ln1_g, ln1_b, nullptr, X1b, H, ada, b_ada, 3, 4);
    SEAM(8);
#ifdef PROBE_NULL9
    if (IN(9)) {
        pg8::Gemm g{H, WGU, M, 2 * DFF, D}; pg8::StaticOrder S; S.init(M, 2 * DFF, G, bx);
        pg8::EpiNull E{(float*)(ws + WS_STATS)};
        pg8::gemm_phase<pg8::EpiNull, pg8::StaticOrder, true, true>(lds + RING_OFF, g, S, E);
    }
#endif
    if (IN(9)) REP(9) {
        pg8::Gemm g{H, WGU, M, 2 * DFF, D}; pg8::StaticOrder S; S.init(M, 2 * DFF, G, bx); SPRB(9)
        pg8::EpiSwiGLU E{ACT, DFF};
        pg8::gemm_phase<pg8::EpiSwiGLU, pg8::StaticOrder, true, true>(lds + RING_OFF, g, S, E);
    }
    SEAM(9);
    if (IN(10)) REP(10) {
        pg8::Gemm g{ACT, WDN, M, D, DFF}; pg8::StaticOrder S; S.init(M, D, G, bx); SPRB(10)
        pg8::EpiRes<true> E{X1b, PREb, D, ada + 5 * D, b_ada + 5 * D, ADAW, SEQ, ALPHA};
        pg8::gemm_phase<pg8::EpiRes<true>, pg8::StaticOrder, true, true>(lds + RING_OFF, g, S, E);
    }
    SEAM(10);
#ifndef DBG_STOP
    if (IN(11)) REP(11) row_pass<2>(gw, NGW, lane, PREb, ln2_g, ln2_b, args.out, nullptr, nullptr, nullptr, nullptr, 0, 0);
#else
    if (IN(11)) {
        const size_t NT = (size_t)G * NWAVES * 64, NE = (size_t)M * D, HN = (size_t)M * 2048;
        for (size_t e = (size_t)vcu * NWAVES * 64 + tid; e < NE; e += NT) {
            float s = 0.f; const size_t eh = e % HN;
            if (DBG_STOP == 1) { s = bflo((unsigned)H[e]) ; }
            if (DBG_STOP == 0) { s = bflo((unsigned)WIN[e]) + bflo((unsigned)WIN[e + NE]) + bflo((unsigned)WGU[e]) + bflo((unsigned)WGU[e + NE]) + bflo((unsigned)WDN[e]) + bflo((unsigned)WOUT[e % ((size_t)D * D)]) + bflo((unsigned)WRET[eh % ((size_t)D * RW)]) + bflo((unsigned)WSG[eh % ((size_t)D * RW)]) + cosT[e % ((size_t)M * 128)] + sinT[e % ((size_t)M * 128)] + ada[e % (2 * ADAW)]; }
            if (DBG_STOP == 2) { s = bflo((unsigned)Qb[eh]) + bflo((unsigned)Kb[eh]) + bflo((unsigned)KTb[eh]) + bflo((unsigned)VTb[eh]) + bflo((unsigned)GSb[eh]) + bflo((unsigned)UGb[eh]) + bflo((unsigned)STb[eh]) + bflo((unsigned)SIGR[e]) + bflo((unsigned)SIGS[e]) + stats[e % ((size_t)M * 64)]; }
#ifndef DBG_P3
#define DBG_P3 3
#endif
            if (DBG_STOP == 3) { s = ((DBG_P3 & 1) ? bflo((unsigned)RGb[e]) : 0.f) + ((DBG_P3 & 2) ? bflo((unsigned)SGU[eh]) : 0.f); }
            if (DBG_STOP == 4) { s = bflo((unsigned)RETG[eh]); }
            if (DBG_STOP == 6) { s = bflo((unsigned)MIX[e]); }
            if (DBG_STOP == 7) { s = bflo((unsigned)PREb[e]); }
            if (DBG_STOP == 8) { s = bflo((unsigned)X1b[e]) + bflo((unsigned)H[e]); }
            if (DBG_STOP == 9) { s = bflo((unsigned)ACT[e]) + bflo((unsigned)ACT[e + NE]); }
            if (DBG_STOP == 10) { s = bflo((unsigned)PREb[e]); }
            args.out[e] = s;
        }
    }
#endif
#ifdef GP_STAMP
    PSTAMP(11);
    if (bx == 0 && tid == 0 && IN(11)) { args.out[0] += (float)prb[PRB_A] * 0.01f; args.out[1] += (float)prb[PRB_B] * 0.01f; }
#endif
#undef IN
#undef SEAM
}

extern "C" void kernel_launch(void* const* d_in, const int* in_sizes, int n_in, void* d_out, int out_size, void* d_ws, size_t ws_size, hipStream_t stream) {
    static int grid = 0;
    if (grid == 0) {
        if (n_in != 19 || in_sizes[0] != M * D || out_size != M * D || ws_size < WS_END) { fprintf(stderr, "kernel_launch: unexpected shapes (n_in %d, in0 %d, out %d, ws %zu)\n", n_in, n_in > 0 ? in_sizes[0] : -1, out_size, ws_size); grid = -1; return; }
        int dev = 0, cus = 0, per_cu = 0;
        if (hipGetDevice(&dev) != hipSuccess || hipDeviceGetAttribute(&cus, hipDeviceAttributeMultiprocessorCount, dev) != hipSuccess) { grid = -1; return; }
        if (hipFuncSetAttribute((const void*)fwd, hipFuncAttributeMaxDynamicSharedMemorySize, LDS_BYTES) != hipSuccess) { fprintf(stderr, "kernel_launch: hipFuncSetAttribute failed\n"); grid = -1; return; }
        if (hipOccupancyMaxActiveBlocksPerMultiprocessor(&per_cu, (const void*)fwd, NWAVES * 64, LDS_BYTES) != hipSuccess || per_cu < 1) fprintf(stderr, "kernel_launch: occupancy query reports %d\n", per_cu);
        (void)hipGetLastError();
        grid = cus;
    }
    if (grid < 0) return;
    if (hipMemsetAsync((char*)d_ws + WS_CTL, 0, CTL_ZERO_BYTES, stream) != hipSuccess) { fprintf(stderr, "kernel_launch: memset failed\n"); return; }
    Args a{};
    for (int i = 0; i < 19; ++i) a.in[i] = (const float*)d_in[i];
    a.out = (float*)d_out; a.ws = (unsigned char*)d_ws;
    if (MK_N_LAUNCHES == 1) { a.ph_lo = 0; a.ph_hi = N_PHASES + 1; hipLaunchKernelGGL(fwd, dim3(grid), dim3(NWAVES * 64), LDS_BYTES, stream, a); }
    else for (int p = 0; p <= N_PHASES; ++p) { a.ph_lo = p; a.ph_hi = p + 1; hipLaunchKernelGGL(fwd, dim3(grid), dim3(NWAVES * 64), LDS_BYTES, stream, a); }
    const hipError_t le = hipPeekAtLastError();
    if (le != hipSuccess) fprintf(stderr, "kernel_launch: launch failed: %s\n", hipGetErrorName(le));
}
```

```cpp
#include <hip/hip_runtime.h>
#include <cstdio>
#include <cstdint>
constexpr int NWAVES = 8;
constexpr int BATCH = 2, SEQ = 4096, D = 4096, M = BATCH * SEQ;
constexpr int RW = 2048, NH = 8, HD = 256, SGW = 2048, NG = 8, GD = 256, CHK = 128, DFF = 11008, INW = 20480, ADAW = 6 * D;
constexpr float LN_EPS = 1e-5f;
constexpr float ALPHA = 1.189207115002721f;
#ifndef MK_N_LAUNCHES
#define MK_N_LAUNCHES 1
#endif
constexpr int N_PHASES = 11;

constexpr size_t MiB = 1u << 20;
constexpr size_t WS_CTL = 0, CTL_ZERO_BYTES = 1 * MiB;
constexpr size_t WS_COS = 1 * MiB, WS_SIN = 5 * MiB, WS_STATS = 9 * MiB;
constexpr size_t WS_WIN = 16 * MiB, WS_WRET = 176 * MiB, WS_WSG = 192 * MiB, WS_WOUT = 208 * MiB, WS_WGU = 240 * MiB, WS_WDN = 412 * MiB;
constexpr size_t WS_H = 498 * MiB, WS_Q = 562 * MiB, WS_K = 594 * MiB, WS_KT = 626 * MiB, WS_VT = 658 * MiB, WS_GS = 690 * MiB, WS_UG = 722 * MiB, WS_ST = 754 * MiB;
constexpr size_t WS_SIGR = 786 * MiB, WS_SIGS = 850 * MiB, WS_RET = 914 * MiB, WS_RETG = 978 * MiB, WS_SGU = 1010 * MiB, WS_MIX = 1042 * MiB, WS_PRE = 1106 * MiB, WS_X1 = 1234 * MiB;
constexpr size_t WS_ACT = 562 * MiB;
constexpr size_t WS_END = 1362 * MiB;
static_assert(WS_WGU + (size_t)2 * DFF * D * 2 <= WS_WDN && WS_WDN + (size_t)D * DFF * 2 <= WS_H && WS_ACT + (size_t)M * DFF * 2 <= WS_ST, "d_ws map");
constexpr int CW_BAR = 4096;
constexpr int CW_WQ = 16384;
constexpr int CW_ADA = 65536;
static_assert((CW_ADA + 2 * ADAW) * 4 <= (int)CTL_ZERO_BYTES, "ctl");

constexpr int RING_OFF = 0, RING_BYTES = 131072;
constexpr int LDSCTL_OFF = RING_BYTES, MISC_OFF = LDSCTL_OFF + 320;
constexpr int LDS_BYTES = 147456;

namespace pg8 {
#define PG8_LAS __attribute__((address_space(3)))
typedef unsigned short bf16_t;
typedef short bf16x8 __attribute__((ext_vector_type(8)));
typedef float f32x4 __attribute__((ext_vector_type(4)));
typedef unsigned u32x4 __attribute__((ext_vector_type(4)));
constexpr int BM = 256, BK = 64, HALF = 128, HTB = HALF * BK * 2  , STAGE_BYTES = 8 * HTB, NXCD = 8, WGM = 8;

__host__ __device__ __forceinline__ int lds_byte(int r, int c) { const int st = (r >> 4) * 2 + (c >> 5), rr = r & 15, cc = c & 31, ob = rr * 64 + cc * 2; return st * 1024 + (ob ^ (((ob >> 9) & 1) << 5)); }
__host__ __device__ __forceinline__ void stage_rc(int b, int& R, int& C) { const int st = b / 1024, sb = b % 1024, swz = sb ^ (((sb >> 9) & 1) << 5); R = (st >> 1) * 16 + swz / 64; C = (st & 1) * 32 + (swz % 64) / 2; }
__host__ __device__ __forceinline__ int perm32(int rho) { const int n = rho >> 4, i = rho & 15; return 8 * (i >> 2) + 4 * n + (i & 3); }

struct Unit { int pm, pn; };
struct Gemm { const bf16_t* A; const bf16_t* Bt; int M, N, K; };

struct StaticOrder {
    int nM, nN, nwg, G, c; unsigned long long* prb = nullptr;
    __host__ __device__ void init(int M, int N, int G_, int c_) { nM = M / BM; nN = N / BM; nwg = nM * nN; G = G_; c = c_; }
    __host__ __device__ bool next(int i, Unit& u) const {
        const long L = (long)i * G + c; if (L >= nwg) return false;
        int wgid = (int)L; { const int q = nwg / NXCD, r = nwg % NXCD, xcd = wgid % NXCD, off = wgid / NXCD; wgid = (xcd < r ? xcd * (q + 1) : r * (q + 1) + (xcd - r) * q) + off; }
        const int nig = WGM * nN, gid = wgid / nig, fm = gid * WGM, gsz = (nM - fm) < WGM ? (nM - fm) : WGM;
        u.pm = fm + ((wgid % nig) % gsz); u.pn = (wgid % nig) / gsz; return true;
    }
    __device__ __forceinline__ void a_ready(const Unit&) const {}
    __device__ __forceinline__ void done(const Unit&) const {}
};
typedef __bf16 bf16v2_t __attribute__((ext_vector_type(2)));
typedef float f32v2_t __attribute__((ext_vector_type(2)));
__device__ __forceinline__ unsigned cvt_pk_bf16(float lo, float hi) { const f32v2_t v = {lo, hi}; const bf16v2_t b = __builtin_convertvector(v, bf16v2_t); return __builtin_bit_cast(unsigned, b); }
typedef float f32x2 __attribute__((ext_vector_type(2)));
typedef unsigned u32x2 __attribute__((ext_vector_type(2)));
__device__ __forceinline__ float fast_sigmoid(float x) { return __builtin_amdgcn_rcpf(1.0f + __builtin_amdgcn_exp2f(-1.4426950408889634f * x)); }
__device__ __forceinline__ float fast_silu(float x) { return x * fast_sigmoid(x); }
__device__ __forceinline__ float gelu_tanh(float x) { const float y = 1.5957691216057308f * (x + 0.044715f * x * x * x); return x * fast_sigmoid(y); }
__device__ __forceinline__ float bf_lo(unsigned w) { return __uint_as_float(w << 16); }
__device__ __forceinline__ float bf_hi(unsigned w) { return __uint_as_float(w & 0xffff0000u); }

__host__ __device__ __forceinline__ int frag_off(int row, int k, int NS) { return ((((row >> 4) * NS + (k >> 5)) * 64 + ((k >> 3) & 3) * 16 + (row & 15)) << 3) + (k & 7); }
__device__ __forceinline__ float log2_gamma(int h) { const float xg = __builtin_amdgcn_exp2f(-5.0f - (float)h); const float x2 = xg * xg; return -1.4426950408889634f * (xg + x2 * 0.5f + x2 * xg * (1.0f / 3.0f) + x2 * x2 * 0.25f + x2 * x2 * xg * 0.2f); }
struct EpiZ {
    static constexpr bool PERM = true, AFTER_DRAIN = false, HAS_MID = false;
    unsigned char* ws; float* stats; const float *cosT, *sinT;
    __device__ __forceinline__ void operator()(const f32x4 (&acc)[2][2][4][2], const Unit& u, int wr, int wc, int fr, int fq) const {
        const int pn = u.pn, row0 = u.pm * BM + wr * 64 + fr, cl = wc * 32 + 8 * fq;
        if (pn < 16) {
            const int h = pn & 7; const bool isk = pn >= 8;
            const float l2g = log2_gamma(h);
            bf16_t* dst = (bf16_t*)(ws + (isk ? WS_K : WS_Q));
#pragma unroll
            for (int ai = 0; ai < 2; ++ai)
#pragma unroll
                for (int m = 0; m < 4; ++m) {
                    const int r = row0 + ai * HALF + m * 16, nloc = r & 127;
                    const float sc = isk ? 0.0625f * __builtin_amdgcn_exp2f(-(float)nloc * l2g) : __builtin_amdgcn_exp2f((float)nloc * l2g);
                    const float* cp = cosT + (size_t)r * 128 + cl; const float* sp = sinT + (size_t)r * 128 + cl;
                    const f32x4 c0 = *(const f32x4*)cp, c1 = *(const f32x4*)(cp + 4), s0 = *(const f32x4*)sp, s1 = *(const f32x4*)(sp + 4);
                    const f32x4 xa = acc[ai][0][m][0], xb = acc[ai][0][m][1], ya = acc[ai][1][m][0], yb = acc[ai][1][m][1];
                    const f32x4 o1a = (xa * c0 - ya * s0) * sc, o1b = (xb * c1 - yb * s1) * sc, o2a = (ya * c0 + xa * s0) * sc, o2b = (yb * c1 + xb * s1) * sc;
                    u32x4 w1, w2; w1.x = cvt_pk_bf16(o1a[0], o1a[1]); w1.y = cvt_pk_bf16(o1a[2], o1a[3]); w1.z = cvt_pk_bf16(o1b[0], o1b[1]); w1.w = cvt_pk_bf16(o1b[2], o1b[3]);
                    w2.x = cvt_pk_bf16(o2a[0], o2a[1]); w2.y = cvt_pk_bf16(o2a[2], o2a[3]); w2.z = cvt_pk_bf16(o2b[0], o2b[1]); w2.w = cvt_pk_bf16(o2b[2], o2b[3]);
                    bf16_t* rowp = dst + (size_t)r * 2048 + 256 * h + cl;
                    *(u32x4*)rowp = w1; *(u32x4*)(rowp + 128) = w2;
                    if (isk) {
                        bf16_t* tb = (bf16_t*)(ws + WS_KT) + (size_t)(((r >> 12) * 8 + h) * 32 + ((r >> 7) & 31)) * 32768;
#pragma unroll
                        for (int q = 0; q < 4; ++q) { const unsigned a = w1[q], b = w2[q];
                            tb[frag_off(cl + 2 * q, r & 127, 4)] = (bf16_t)(a & 0xffffu); tb[frag_off(cl + 2 * q + 1, r & 127, 4)] = (bf16_t)(a >> 16);
                            tb[frag_off(128 + cl + 2 * q, r & 127, 4)] = (bf16_t)(b & 0xffffu); tb[frag_off(128 + cl + 2 * q + 1, r & 127, 4)] = (bf16_t)(b >> 16); }
                    }
                    asm volatile("" ::: "memory");
                }
        } else if (pn < 24 || (pn >= 40 && pn < 48)) {
            const bool iss = pn >= 40; bf16_t* T = (bf16_t*)(ws + (iss ? WS_ST : WS_VT)); const int ct = (iss ? pn - 40 : pn - 16) * 256;
#pragma unroll
            for (int ai = 0; ai < 2; ++ai)
#pragma unroll
                for (int m = 0; m < 4; ++m) {
                    const int r = row0 + ai * HALF + m * 16; float sum = 0.f, sq = 0.f;
#pragma unroll
                    for (int bj = 0; bj < 2; ++bj)
#pragma unroll
                        for (int n = 0; n < 2; ++n) {
                            f32x4 v = acc[ai][bj][m][n];
                            if (iss) { v[0] = gelu_tanh(v[0]); v[1] = gelu_tanh(v[1]); v[2] = gelu_tanh(v[2]); v[3] = gelu_tanh(v[3]); }
                            const unsigned a = cvt_pk_bf16(v[0], v[1]), b = cvt_pk_bf16(v[2], v[3]);
                            if (iss) { const float f0 = bf_lo(a), f1 = bf_hi(a), f2 = bf_lo(b), f3 = bf_hi(b); sum += (f0 + f1) + (f2 + f3); sq += (f0 * f0 + f1 * f1) + (f2 * f2 + f3 * f3); }
                            const int cc = ct + bj * HALF + cl + 4 * n, rr = iss ? cc : (cc & 255);
                            bf16_t* t = T + (iss ? (size_t)(r >> 7) * 262144 : (size_t)(((r >> 12) * 8 + (ct >> 8)) * 32 + ((r >> 7) & 31)) * 32768);
                            t[frag_off(rr, r & 127, 4)] = (bf16_t)(a & 0xffffu); t[frag_off(rr + 1, r & 127, 4)] = (bf16_t)(a >> 16); t[frag_off(rr + 2, r & 127, 4)] = (bf16_t)(b & 0xffffu); t[frag_off(rr + 3, r & 127, 4)] = (bf16_t)(b >> 16);
                        }
                    if (iss) {
                        sum += __shfl_xor(sum, 16); sum += __shfl_xor(sum, 32); sq += __shfl_xor(sq, 16); sq += __shfl_xor(sq, 32);
                        if (fq == 0) { f32x2 o; o.x = sum; o.y = sq; *(f32x2*)(stats + (size_t)r * 64 + ((pn - 40) * 4 + wc) * 2) = o; }
                    }
                    asm volatile("" ::: "memory");
                }
        } else {
            const int kind = pn < 32 ? 0 : (pn < 40 ? 1 : 2);
            size_t doff; int ldc, ct;
            if (pn < 32) { doff = WS_GS; ldc = 2048; ct = (pn - 24) * 256; } else if (pn < 40) { doff = WS_UG; ldc = 2048; ct = (pn - 32) * 256; }
            else if (pn < 64) { doff = WS_SIGR; ldc = 4096; ct = (pn - 48) * 256; } else { doff = WS_SIGS; ldc = 4096; ct = (pn - 64) * 256; }
            bf16_t* dst = (bf16_t*)(ws + doff);
#pragma unroll
            for (int ai = 0; ai < 2; ++ai)
#pragma unroll
                for (int m = 0; m < 4; ++m) {
                    const int r = row0 + ai * HALF + m * 16; bf16_t* rowp = dst + (size_t)r * ldc + ct + cl;
#pragma unroll
                    for (int bj = 0; bj < 2; ++bj) {
                        f32x4 v0 = acc[ai][bj][m][0], v1 = acc[ai][bj][m][1];
#pragma unroll
                        for (int j = 0; j < 4; ++j) {
                            if (kind == 0) { v0[j] = fast_silu(v0[j]); v1[j] = fast_silu(v1[j]); }
                            else if (kind == 1) { v0[j] = gelu_tanh(v0[j]); v1[j] = gelu_tanh(v1[j]); }
                            else { v0[j] = fast_sigmoid(v0[j]); v1[j] = fast_sigmoid(v1[j]); } }
                        u32x4 w; w.x = cvt_pk_bf16(v0[0], v0[1]); w.y = cvt_pk_bf16(v0[2], v0[3]); w.z = cvt_pk_bf16(v1[0], v1[1]); w.w = cvt_pk_bf16(v1[2], v1[3]);
                        *(u32x4*)(rowp + bj * HALF) = w; }
                }
        }
    }
};

struct EpiSwiGLU {
    static constexpr bool PERM = true, AFTER_DRAIN = false, HAS_MID = false;
    bf16_t* O; int ldc;
    __device__ __forceinline__ void operator()(const f32x4 (&acc)[2][2][4][2], const Unit& u, int wr, int wc, int fr, int fq) const {
        const int row0 = u.pm * BM + wr * 64 + fr, col0 = u.pn * HALF + wc * 32 + 8 * fq;
#pragma unroll
        for (int ai = 0; ai < 2; ++ai)
#pragma unroll
            for (int m = 0; m < 4; ++m) {
                const f32x4 g0 = acc[ai][0][m][0], g1 = acc[ai][0][m][1], u0 = acc[ai][1][m][0], u1 = acc[ai][1][m][1]; f32x4 v0, v1;
#pragma unroll
                for (int j = 0; j < 4; ++j) { v0[j] = fast_silu(g0[j]) * u0[j]; v1[j] = fast_silu(g1[j]) * u1[j]; }
                u32x4 w; w.x = cvt_pk_bf16(v0[0], v0[1]); w.y = cvt_pk_bf16(v0[2], v0[3]); w.z = cvt_pk_bf16(v1[0], v1[1]); w.w = cvt_pk_bf16(v1[2], v1[3]);
                *(u32x4*)(O + (size_t)(row0 + ai * HALF + m * 16) * ldc + col0) = w; }
    }
};

template <int MODE> struct EpiMix {
    static constexpr bool PERM = false, AFTER_DRAIN = false, HAS_MID = false;
    const bf16_t* gate; float* T; bf16_t* O; int ldc;
    __device__ __forceinline__ void operator()(const f32x4 (&acc)[2][2][4][2], const Unit& u, int wr, int wc, int fr, int fq) const {
        const int row0 = u.pm * BM + wr * 64 + fr, col0 = u.pn * BM + wc * 32 + 4 * fq;
#pragma unroll
        for (int ai = 0; ai < 2; ++ai)
#pragma unroll
            for (int m = 0; m < 4; ++m) { const size_t off = (size_t)(row0 + ai * HALF + m * 16) * ldc + col0;
#pragma unroll
                for (int bj = 0; bj < 2; ++bj)
#pragma unroll
                    for (int n = 0; n < 2; ++n) { const size_t o = off + bj * HALF + n * 16;
                        const u32x2 gw = *(const u32x2*)(gate + o); const f32x4 gv = (f32x4){bf_lo(gw.x), bf_hi(gw.x), bf_lo(gw.y), bf_hi(gw.y)};
                        if (MODE == 0) { *(f32x4*)(T + o) = gv * acc[ai][bj][m][n]; }
                        else { const f32x4 v = *(const f32x4*)(T + o) + gv * acc[ai][bj][m][n]; u32x2 w; w.x = cvt_pk_bf16(v[0], v[1]); w.y = cvt_pk_bf16(v[2], v[3]); *(u32x2*)(O + o) = w; } } }
    }
};

template <bool RES_BF16> struct EpiRes {
    static constexpr bool PERM = true, AFTER_DRAIN = false, HAS_MID = false;
    const void* res; bf16_t* P; int ldc; const float* ga; const float* gb; int ga_stride; int rows_per_batch; float alpha;
    __device__ __forceinline__ void operator()(const f32x4 (&acc)[2][2][4][2], const Unit& u, int wr, int wc, int fr, int fq) const {
        const int row0 = u.pm * BM + wr * 64 + fr, col0 = u.pn * BM + wc * 32 + 8 * fq; const int b = (u.pm * BM) / rows_per_batch;
        f32x4 gv[2][2];
#pragma unroll
        for (int bj = 0; bj < 2; ++bj)
#pragma unroll
            for (int n = 0; n < 2; ++n) gv[bj][n] = *(const f32x4*)(ga + (size_t)b * ga_stride + col0 + bj * HALF + n * 4) + *(const f32x4*)(gb + col0 + bj * HALF + n * 4) + 1.0f;
#pragma unroll
        for (int ai = 0; ai < 2; ++ai)
#pragma unroll
            for (int m = 0; m < 4; ++m) { const size_t off = (size_t)(row0 + ai * HALF + m * 16) * ldc + col0;
#pragma unroll
                for (int bj = 0; bj < 2; ++bj) { const size_t o = off + bj * HALF;
                    f32x4 r0, r1;
                    if (RES_BF16) { const u32x4 rw = *(const u32x4*)((const bf16_t*)res + o); r0 = (f32x4){bf_lo(rw.x), bf_hi(rw.x), bf_lo(rw.y), bf_hi(rw.y)}; r1 = (f32x4){bf_lo(rw.z), bf_hi(rw.z), bf_lo(rw.w), bf_hi(rw.w)}; }
                    else { r0 = *(const f32x4*)((const float*)res + o); r1 = *(const f32x4*)((const float*)res + o + 4); }
                    const f32x4 v0 = r0 * alpha + gv[bj][0] * acc[ai][bj][m][0], v1 = r1 * alpha + gv[bj][1] * acc[ai][bj][m][1];
                    u32x4 w; w.x = cvt_pk_bf16(v0[0], v0[1]); w.y = cvt_pk_bf16(v0[2], v0[3]); w.z = cvt_pk_bf16(v1[0], v1[1]); w.w = cvt_pk_bf16(v1[2], v1[3]);
                    *(u32x4*)(P + o) = w; } }
    }
};

struct EpiMixCat {
    static constexpr bool PERM = true, AFTER_DRAIN = false, HAS_MID = true;
    const bf16_t* SR; const bf16_t* SS; bf16_t* O; int ldc;
    __device__ __forceinline__ void mid(f32x4 (&acc)[2][2][4][2], const Unit& u, int wr, int wc, int fr, int fq) const {
        unsigned boff = (unsigned)((u.pm * BM + wr * 64 + fr) * ldc + u.pn * BM + wc * 32 + 8 * fq) * 2u; asm volatile("" : "+v"(boff));
        const __attribute__((address_space(1))) char* sr = (const __attribute__((address_space(1))) char*)SR; const __attribute__((address_space(1))) char* ss = (const __attribute__((address_space(1))) char*)SS;
#pragma unroll
        for (int ai = 0; ai < 2; ++ai)
#pragma unroll
            for (int m = 0; m < 4; ++m) {
#pragma unroll
                for (int bj = 0; bj < 2; ++bj) { const unsigned o = boff + (unsigned)((ai * HALF + m * 16) * ldc + bj * HALF) * 2u;
                    const u32x4 a = *(const __attribute__((address_space(1))) u32x4*)(sr + o), b = *(const __attribute__((address_space(1))) u32x4*)(ss + o);
#pragma unroll
                    for (int q = 0; q < 4; ++q) { const float r0 = bf_lo(a[q]) * __builtin_amdgcn_rcpf(fmaxf(bf_lo(b[q]), 1e-20f)), r1 = bf_hi(a[q]) * __builtin_amdgcn_rcpf(fmaxf(bf_hi(b[q]), 1e-20f));
                        acc[ai][bj][m][q >> 1][(q & 1) * 2] *= r0; acc[ai][bj][m][q >> 1][(q & 1) * 2 + 1] *= r1; } }
                asm volatile("" ::: "memory"); }
    }
    __device__ __forceinline__ void operator()(const f32x4 (&acc)[2][2][4][2], const Unit& u, int wr, int wc, int fr, int fq) const {
        const int row0 = u.pm * BM + wr * 64 + fr, col0 = u.pn * BM + wc * 32 + 8 * fq;
#pragma unroll
        for (int ai = 0; ai < 2; ++ai)
#pragma unroll
            for (int m = 0; m < 4; ++m) { const size_t off = (size_t)(row0 + ai * HALF + m * 16) * ldc + col0;
#pragma unroll
                for (int bj = 0; bj < 2; ++bj) { const u32x4 b = *(const u32x4*)(SS + off + bj * HALF); u32x4 w;
#pragma unroll
                    for (int q = 0; q < 4; ++q) { const float s0 = fmaxf(bf_lo(b[q]), 1e-20f), s1 = fmaxf(bf_hi(b[q]), 1e-20f);
                        w[q] = cvt_pk_bf16(acc[ai][bj][m][q >> 1][(q & 1) * 2] * s0, acc[ai][bj][m][q >> 1][(q & 1) * 2 + 1] * s1); }
                    *(u32x4*)(O + off + bj * HALF) = w; } }
    }
};

struct EpiNull {
    static constexpr bool PERM = true, AFTER_DRAIN = false, HAS_MID = false;
    float* sink;
    __device__ __forceinline__ void operator()(const f32x4 (&acc)[2][2][4][2], const Unit& u, int wr, int wc, int fr, int fq) const {
        float s = 0.f;
#pragma unroll
        for (int ai = 0; ai < 2; ++ai)
#pragma unroll
            for (int bj = 0; bj < 2; ++bj)
#pragma unroll
                for (int m = 0; m < 4; ++m)
#pragma unroll
                    for (int n = 0; n < 2; ++n) s += (acc[ai][bj][m][n][0] + acc[ai][bj][m][n][1]) + (acc[ai][bj][m][n][2] + acc[ai][bj][m][n][3]);
        if (s == 123456.789f) sink[0] = s;
    }
};
template <class Epi, class Sched, bool ALIGN_EPI = false, bool SP2 = false>
__device__ __forceinline__ void gemm_phase(PG8_LAS unsigned char* lds, const Gemm g, const Sched& S, const Epi& E) {
    int tid = threadIdx.x; asm volatile("" : "+v"(tid));
    const int wid = __builtin_amdgcn_readfirstlane(tid >> 6), lane = tid & 63, wr = wid >> 2, wc = wid & 3, fr = lane & 15, fq = lane >> 4;
    const int K = g.K, nt = K / BK;
    unsigned voffA[2], voffB[2];
#pragma unroll
    for (int i = 0; i < 2; ++i) { int R, C; stage_rc(tid * 16 + i * 8192, R, C); const int Rb = Epi::PERM ? ((R & ~31) + perm32(R & 31)) : R;
        voffA[i] = (unsigned)(R * K + C) * 2u; voffB[i] = (unsigned)(Rb * K + C) * 2u; }
    const size_t kstep = (size_t)(BK * 2);
    const size_t hstep = (size_t)HALF * K * 2;
    const size_t tstep = 2 * hstep;
    const unsigned ldsw = (unsigned)wid * 1024u;
    const int aoff = lds_byte(wr * 64 + fr, fq * 8), boff = lds_byte(wc * 32 + fr, fq * 8);
#define PG8_SA(b, h) (((b) * 2 + (h)) * HTB)
#define PG8_SB(b, h) ((4 + (b) * 2 + (h)) * HTB)
#define PG8_STAGE(bufoff, gbase, voff) do { _Pragma("unroll") for (int _i = 0; _i < 2; ++_i) \
        __builtin_amdgcn_global_load_lds((const unsigned*)((const char*)(gbase) + (voff)[_i]), (PG8_LAS unsigned*)(lds + (bufoff) + ldsw + _i * 8192), 16, 0, 0); } while (0)
#define PG8_LDA(dst, b, h) do { _Pragma("unroll") for (int m = 0; m < 4; ++m) _Pragma("unroll") for (int k = 0; k < 2; ++k) dst[m][k] = *(const PG8_LAS bf16x8*)(lds + PG8_SA(b, h) + aoff + m * 2048 + k * 1024); } while (0)
#define PG8_LDB(dst, b, h) do { _Pragma("unroll") for (int n = 0; n < 2; ++n) _Pragma("unroll") for (int k = 0; k < 2; ++k) dst[n][k] = *(const PG8_LAS bf16x8*)(lds + PG8_SB(b, h) + boff + n * 2048 + k * 1024); } while (0)
#define PG8_MMA(ai, bj, At, Bt) do { __builtin_amdgcn_s_setprio(1); _Pragma("unroll") for (int m = 0; m < 4; ++m) _Pragma("unroll") for (int n = 0; n < 2; ++n) _Pragma("unroll") for (int k = 0; k < 2; ++k) \
        acc[ai][bj][m][n] = __builtin_amdgcn_mfma_f32_16x16x32_bf16(Bt[n][k], At[m][k], acc[ai][bj][m][n], 0, 0, 0); __builtin_amdgcn_s_setprio(0); } while (0)
#define PG8_WAIT_V(n) asm volatile("s_waitcnt vmcnt(" #n ")" ::: "memory")
#define PG8_WAIT_L(n) asm volatile("s_waitcnt lgkmcnt(" #n ")" ::: "memory")
#define PG8_BAR __builtin_amdgcn_s_barrier()
#define PG8_SCHED __builtin_amdgcn_sched_barrier(0)
    Unit cur, nxt; int ui = 0;
    if (!S.next(0, cur)) return;
    f32x4 acc[2][2][4][2];
#pragma unroll
    for (int a = 0; a < 2; ++a)
#pragma unroll
        for (int b = 0; b < 2; ++b)
#pragma unroll
            for (int m = 0; m < 4; ++m)
#pragma unroll
                for (int n = 0; n < 2; ++n) acc[a][b][m][n] = (f32x4){0.f, 0.f, 0.f, 0.f};
    bf16x8 At[4][2], B0[2][2], B1[2][2];
    const char* cA = (const char*)g.A + (size_t)cur.pm * tstep; const char* cB = (const char*)g.Bt + (size_t)cur.pn * tstep;
    S.a_ready(cur);
    if constexpr (SP2) {
        PG8_STAGE(PG8_SB(0, 0), cB, voffB); PG8_STAGE(PG8_SB(0, 1), cB + hstep, voffB); PG8_STAGE(PG8_SA(0, 0), cA, voffA); PG8_STAGE(PG8_SA(0, 1), cA + hstep, voffA);
        if (wr == 1) PG8_BAR;
        PG8_WAIT_V(2); PG8_BAR;
        PG8_STAGE(PG8_SB(1, 0), cB + kstep, voffB); PG8_STAGE(PG8_SA(1, 0), cA + kstep, voffA); PG8_STAGE(PG8_SB(1, 1), cB + hstep + kstep, voffB);
        PG8_WAIT_V(6); PG8_BAR;
    } else {
        PG8_STAGE(PG8_SB(0, 0), cB, voffB); PG8_STAGE(PG8_SA(0, 0), cA, voffA); PG8_STAGE(PG8_SB(0, 1), cB + hstep, voffB); PG8_STAGE(PG8_SA(0, 1), cA + hstep, voffA);
        if (wr == 1) PG8_BAR;
        PG8_WAIT_V(4); PG8_BAR;
        PG8_STAGE(PG8_SB(1, 0), cB + kstep, voffB); PG8_STAGE(PG8_SA(1, 0), cA + kstep, voffA); PG8_STAGE(PG8_SB(1, 1), cB + hstep + kstep, voffB);
        PG8_WAIT_V(6); PG8_BAR;
    }
#ifdef GP_STAMP
    unsigned long long gp_tk = 0, gp_te = 0, gp_tf = 0, gp_ts = __builtin_amdgcn_s_memrealtime(), gp_tm = 0;
#endif
    for (;;) {
        const bool has_next = S.next(ui + 1, nxt);
        const char* nA = has_next ? (const char*)g.A + (size_t)nxt.pm * tstep : cA; const char* nB = has_next ? (const char*)g.Bt + (size_t)nxt.pn * tstep : cB;
        for (int t = 0; t < nt; t += 2) {
            if constexpr (Epi::HAS_MID) { if (t == (nt >> 1)) E.mid(acc, cur, wr, wc, fr, fq); }
#ifdef GP_STAMP
            if (t == 4) gp_tf += __builtin_amdgcn_s_memrealtime() - gp_ts;
#endif
            const bool last = (t == nt - 2);
            const char* a1 = cA + (size_t)(t + 1) * kstep;
            const char* a2 = last ? nA : cA + (size_t)(t + 2) * kstep; const char* b2 = last ? nB : cB + (size_t)(t + 2) * kstep;
            const char* a3 = a2 + kstep; const char* b3 = b2 + kstep;
            if (last && has_next) S.a_ready(nxt);
            if constexpr (SP2) {
            PG8_LDB(B0, 0, 0); PG8_LDB(B1, 0, 1); PG8_SCHED; PG8_LDA(At, 0, 0); PG8_STAGE(PG8_SA(1, 1), a1 + hstep, voffA);
            PG8_WAIT_V(8); PG8_WAIT_L(0); PG8_BAR; PG8_MMA(0, 0, At, B0); PG8_MMA(0, 1, At, B1); PG8_BAR; PG8_SCHED;
            PG8_LDA(At, 0, 1); PG8_STAGE(PG8_SB(0, 0), b2, voffB); PG8_STAGE(PG8_SB(0, 1), b2 + hstep, voffB); PG8_STAGE(PG8_SA(0, 0), a2, voffA);
            PG8_WAIT_V(8); PG8_WAIT_L(0); PG8_BAR; PG8_MMA(1, 0, At, B0); PG8_MMA(1, 1, At, B1); PG8_BAR; PG8_SCHED;
            PG8_LDB(B0, 1, 0); PG8_LDB(B1, 1, 1); PG8_SCHED; PG8_LDA(At, 1, 0); PG8_STAGE(PG8_SA(0, 1), a2 + hstep, voffA);
            PG8_WAIT_V(8); PG8_WAIT_L(0); PG8_BAR; PG8_MMA(0, 0, At, B0); PG8_MMA(0, 1, At, B1); PG8_BAR; PG8_SCHED;
            PG8_LDA(At, 1, 1); PG8_STAGE(PG8_SB(1, 0), b3, voffB); PG8_STAGE(PG8_SB(1, 1), b3 + hstep, voffB); PG8_STAGE(PG8_SA(1, 0), a3, voffA);
            PG8_WAIT_V(8); PG8_WAIT_L(0); PG8_BAR; PG8_MMA(1, 0, At, B0); PG8_MMA(1, 1, At, B1); PG8_BAR; PG8_SCHED;
            } else {
            PG8_LDB(B0, 0, 0); PG8_SCHED; PG8_LDA(At, 0, 0); PG8_STAGE(PG8_SA(1, 1), a1 + hstep, voffA);
            PG8_WAIT_L(8); PG8_BAR; PG8_WAIT_L(0); PG8_MMA(0, 0, At, B0); PG8_BAR; PG8_SCHED;
            PG8_LDB(B1, 0, 1); PG8_STAGE(PG8_SB(0, 0), b2, voffB);
            PG8_BAR; PG8_WAIT_L(0); PG8_MMA(0, 1, At, B1); PG8_BAR;
            PG8_LDA(At, 0, 1); PG8_STAGE(PG8_SA(0, 0), a2, voffA);
            PG8_BAR; PG8_WAIT_L(0); PG8_MMA(1, 0, At, B0); PG8_BAR; PG8_SCHED;
            PG8_STAGE(PG8_SB(0, 1), b2 + hstep, voffB);
            PG8_WAIT_V(6); PG8_BAR; PG8_MMA(1, 1, At, B1); PG8_BAR;
            PG8_LDB(B0, 1, 0); PG8_SCHED; PG8_LDA(At, 1, 0); PG8_STAGE(PG8_SA(0, 1), a2 + hstep, voffA);
            PG8_WAIT_L(8); PG8_BAR; PG8_WAIT_L(0); PG8_MMA(0, 0, At, B0); PG8_BAR; PG8_SCHED;
            PG8_LDB(B1, 1, 1); PG8_STAGE(PG8_SB(1, 0), b3, voffB);
            PG8_BAR; PG8_WAIT_L(0); PG8_MMA(0, 1, At, B1); PG8_BAR;
            PG8_LDA(At, 1, 1); PG8_STAGE(PG8_SA(1, 0), a3, voffA);
            PG8_BAR; PG8_WAIT_L(0); PG8_MMA(1, 0, At, B0); PG8_BAR; PG8_SCHED;
            PG8_STAGE(PG8_SB(1, 1), b3 + hstep, voffB);
            PG8_WAIT_V(6); PG8_BAR; PG8_MMA(1, 1, At, B1); PG8_BAR;
            }
        }
#ifdef GP_STAMP
        gp_tm = __builtin_amdgcn_s_memrealtime(); gp_tk += gp_tm - gp_ts;
#endif
        if constexpr (ALIGN_EPI) { if (wr == 0) PG8_BAR; }
        if constexpr (!Epi::AFTER_DRAIN) { E(acc, cur, wr, wc, fr, fq); S.done(cur); }
        if (!has_next) break;
#pragma unroll
        for (int a = 0; a < 2; ++a)
#pragma unroll
            for (int b = 0; b < 2; ++b)
#pragma unroll
                for (int m = 0; m < 4; ++m)
#pragma unroll
                    for (int n = 0; n < 2; ++n) acc[a][b][m][n] = (f32x4){0.f, 0.f, 0.f, 0.f};
        cur = nxt; cA = nA; cB = nB; ++ui;
        if constexpr (ALIGN_EPI) { if (wr == 1) PG8_BAR; }
#ifdef GP_STAMP
        gp_ts = __builtin_amdgcn_s_memrealtime(); gp_te += gp_ts - gp_tm;
#endif
    }
#ifdef GP_STAMP
    if (S.prb && blockIdx.x == 0 && threadIdx.x == 0) { S.prb[0] += gp_tk; S.prb[1] += gp_te + (__builtin_amdgcn_s_memrealtime() - gp_tm); S.prb[2] += gp_tf; }
#endif
    PG8_WAIT_V(0);
    if constexpr (!ALIGN_EPI) { if (wr == 0) PG8_BAR; }
    PG8_BAR;
    if constexpr (Epi::AFTER_DRAIN) { E.fused(acc, cur, wr, wc, fr, fq, lds, wid, lane); S.done(cur); }
#undef PG8_SA
#undef PG8_SB
#undef PG8_STAGE
#undef PG8_LDA
#undef PG8_LDB
#undef PG8_MMA
#undef PG8_WAIT_V
#undef PG8_WAIT_L
#undef PG8_BAR
#undef PG8_SCHED
}
}
#define GAS __attribute__((address_space(1)))
#define LAS __attribute__((address_space(3)))
typedef unsigned short bf16;
typedef unsigned v4u __attribute__((ext_vector_type(4)));
typedef float f32x4 __attribute__((ext_vector_type(4)));
typedef short bf16x8 __attribute__((ext_vector_type(8)));
typedef GAS unsigned gu32;
typedef GAS unsigned long long gu64;
#define RLX_AGENT __ATOMIC_RELAXED, __HIP_MEMORY_SCOPE_AGENT
#define LDS_WAIT() asm volatile("s_waitcnt lgkmcnt(0)" ::: "memory")
#define VM_WAIT() asm volatile("s_waitcnt vmcnt(0)" ::: "memory")
__device__ __forceinline__ unsigned long long rt() { return __builtin_amdgcn_s_memrealtime(); }
__device__ __forceinline__ unsigned f2bf(float f) { unsigned u = __builtin_bit_cast(unsigned, f); return (u + 0x7fffu + ((u >> 16) & 1u)) >> 16; }
__device__ __forceinline__ unsigned pk2(float lo, float hi) { return f2bf(lo) | (f2bf(hi) << 16); }
#define XB_TMO      128
#define XB_XCNT(j)  (256  + 64 * (j))
#define XB_XSUB(j)  (1280 + 64 * (j))
#define XB_XGEN(j)  (2304 + 64 * (j))
#define XB_TOP      3328
#define XB_TOPGEN   3392
#define XCD_BAR_WORDS 3456
#define XB_SPIN_CAP (1u << 18)

__device__ __forceinline__ unsigned xb_ld(unsigned* p)              { return __hip_atomic_load(p, __ATOMIC_RELAXED, __HIP_MEMORY_SCOPE_AGENT); }
__device__ __forceinline__ unsigned xb_add(unsigned* p, unsigned v) { return __hip_atomic_fetch_add(p, v, __ATOMIC_RELAXED, __HIP_MEMORY_SCOPE_AGENT); }
__device__ __forceinline__ unsigned xb_xcc_id() { return (unsigned)__builtin_amdgcn_s_getreg((3 << 11) | 20) & 0xFu; }
#define XB_SPIN(cond, bar) do { unsigned _sp = 0; while (cond) { __builtin_amdgcn_s_sleep(1); \
    if ((++_sp & 255u) == 0u) { if (xb_ld(&(bar)[XB_TMO])) break; if (_sp > XB_SPIN_CAP) { atomicAdd(&(bar)[XB_TMO], 1u); break; } } } } while (0)

struct XcdBarrier {
    unsigned* bar; unsigned x;
    volatile LAS unsigned* st;
};

__device__ __forceinline__ XcdBarrier xcd_barrier_post(unsigned* bar, volatile LAS unsigned* st) {
    XcdBarrier b; b.bar = bar; b.x = xb_xcc_id(); b.st = st;
    if (threadIdx.x == 0) (void)xb_add(&bar[XB_XCNT(b.x)], 1u);
    return b;
}
__device__ __forceinline__ void xcd_barrier_complete(unsigned* bar, unsigned x, unsigned& nloc, unsigned& nx) {
    const unsigned G = gridDim.x * gridDim.y * gridDim.z;
    unsigned sum, cnt, mine, sp = 0u;
    for (;;) {
        sum = 0u; cnt = 0u; mine = 0u;
#pragma unroll
        for (unsigned j = 0; j < 16; ++j) { const unsigned c = xb_ld(&bar[XB_XCNT(j)]); sum += c; cnt += (c > 0u) ? 1u : 0u; mine = (j == x) ? c : mine; }
        if (sum == G) break;
        __builtin_amdgcn_s_sleep(1);
        if ((++sp & 255u) == 0u) { if (xb_ld(&bar[XB_TMO])) break; if (sp > XB_SPIN_CAP) { atomicAdd(&bar[XB_TMO], 1u); break; } }
    }
    nloc = mine > 0u ? mine : 1u; nx = cnt > 0u ? cnt : 1u;
}

__device__ __forceinline__ void xcd_barrier(const XcdBarrier& b) {
    asm volatile("s_waitcnt vmcnt(0)" ::: "memory");
    __syncthreads();
    if (threadIdx.x == 0) {
        unsigned* bar = b.bar;
        __builtin_amdgcn_s_waitcnt(0);
        unsigned nloc = b.st[0], nx = b.st[1];
        if (nloc == 0u) { xcd_barrier_complete(bar, b.x, nloc, nx); b.st[0] = nloc; b.st[1] = nx; }
        const unsigned old = xb_add(&bar[XB_XSUB(b.x)], 1u);
        const unsigned gen = old / nloc;
        if (old + 1u == (gen + 1u) * nloc) {
            __builtin_amdgcn_fence(__ATOMIC_RELEASE, "agent");
            asm volatile("s_waitcnt vmcnt(0)" ::: "memory");
            const unsigned og = xb_add(&bar[XB_TOP], 1u);
            const unsigned tg = og / nx;
            if (og + 1u == (tg + 1u) * nx) xb_add(&bar[XB_TOPGEN], 1u);
            else XB_SPIN(xb_ld(&bar[XB_TOPGEN]) == tg, bar);
            __builtin_amdgcn_fence(__ATOMIC_ACQUIRE, "agent");
            xb_add(&bar[XB_XGEN(b.x)], 1u);
            asm volatile("s_waitcnt vmcnt(0)" ::: "memory");
        } else {
            XB_SPIN(xb_ld(&bar[XB_XGEN(b.x)]) == gen, bar);
            __builtin_amdgcn_fence(__ATOMIC_ACQUIRE, "agent");
            asm volatile("s_waitcnt vmcnt(0)" ::: "memory");
        }
    }
    __syncthreads();
}

typedef unsigned u32x2 __attribute__((ext_vector_type(2)));
typedef float f32x2 __attribute__((ext_vector_type(2)));
#define MFMA16(a, b, c) __builtin_amdgcn_mfma_f32_16x16x32_bf16((a), (b), (c), 0, 0, 0)
__device__ __forceinline__ float wave_sum(float v) {
#pragma unroll
    for (int o = 1; o < 64; o <<= 1) v += __shfl_xor(v, o);
    return v;
}
__device__ __forceinline__ float bflo(unsigned w) { return __uint_as_float(w << 16); }
__device__ __forceinline__ float bfhi(unsigned w) { return __uint_as_float(w & 0xffff0000u); }
__device__ __forceinline__ unsigned pkbf(float lo, float hi) { return pg8::cvt_pk_bf16(lo, hi); }

struct Args { const float* in[19]; float* out; unsigned char* ws; int ph_lo, ph_hi; };

__device__ __forceinline__ void p0_transpose_item(const float* W, int K, int N, bf16* WT, int kb, int n0, int row0, int lane, int ldt = 0, int koff = 0) {
    const GAS float* src = (const GAS float*)W + (size_t)(kb * 64) * N + n0 + lane;
    float v[64];
#pragma unroll
    for (int i = 0; i < 64; ++i) v[i] = src[(size_t)i * N];
    GAS v4u* dst = (GAS v4u*)((GAS bf16*)WT + (size_t)(row0 + lane) * (ldt ? ldt : K) + koff + kb * 64);
#pragma unroll
    for (int c = 0; c < 8; ++c) { v4u o; o.x = pkbf(v[8 * c], v[8 * c + 1]); o.y = pkbf(v[8 * c + 2], v[8 * c + 3]); o.z = pkbf(v[8 * c + 4], v[8 * c + 5]); o.w = pkbf(v[8 * c + 6], v[8 * c + 7]); dst[c] = o; }
}
__device__ __forceinline__ int gu_row0(int n0) {
    const int up = n0 >= DFF ? 1 : 0, j = n0 - up * DFF; return 256 * (j >> 7) + 128 * up + (j & 127);
}

template <int MODE> __device__ __forceinline__ void row_pass(int gw, int NGW, int lane, const void* src, const float* lg, const float* lb, float* Yf, bf16* Yb, bf16* H,
                                                             const float* ada, const float* bada, int seg_sh, int seg_sc) {
#define RP_F4(base, boff) (*(const GAS f32x4*)((const GAS char*)(base) + (boff)))
#define RP_U4(base, boff) (*(const GAS v4u*)((const GAS char*)(base) + (boff)))
    for (int row = gw; row < M; row += NGW) {
        const int b = row / SEQ;
        unsigned l16; asm volatile("v_lshlrev_b32 %0, 4, %1" : "=v"(l16) : "v"(lane));
        const unsigned l32 = 2u * l16;
        f32x4 v[8][2];
        if (MODE == 0) {
            const float* sp = (const float*)src + (size_t)row * D;
#pragma unroll
            for (int j = 0; j < 8; ++j) { v[j][0] = RP_F4(sp, 2048u * j + l32); v[j][1] = RP_F4(sp, 2048u * j + 16u + l32); }
        } else {
            const bf16* sp = (const bf16*)src + (size_t)row * D;
#pragma unroll
            for (int j = 0; j < 8; ++j) { const v4u w = RP_U4(sp, 1024u * j + l16); v[j][0] = (f32x4){bflo(w.x), bfhi(w.x), bflo(w.y), bfhi(w.y)}; v[j][1] = (f32x4){bflo(w.z), bfhi(w.z), bflo(w.w), bfhi(w.w)}; }
            float s = 0.f;
#pragma unroll
            for (int j = 0; j < 8; ++j) s += ((v[j][0].x + v[j][0].y) + (v[j][0].z + v[j][0].w)) + ((v[j][1].x + v[j][1].y) + (v[j][1].z + v[j][1].w));
            const float mean = wave_sum(s) * (1.f / D); float s2 = 0.f;
#pragma unroll
            for (int j = 0; j < 8; ++j)
#pragma unroll
                for (int q = 0; q < 2; ++q) { v[j][q] = v[j][q] - mean; s2 += (v[j][q].x * v[j][q].x + v[j][q].y * v[j][q].y) + (v[j][q].z * v[j][q].z + v[j][q].w * v[j][q].w); }
            const float rstd = 1.0f / sqrtf(wave_sum(s2) * (1.f / D) + LN_EPS);
            const float* ash = ada + (size_t)b * ADAW + seg_sh * D; const float* bsh = bada + seg_sh * D;
            const float* asc = ada + (size_t)b * ADAW + seg_sc * D; const float* bsc = bada + seg_sc * D;
            float* ypf = Yf + (size_t)row * D; bf16* ypb = Yb + (size_t)row * D; bf16* hp = H + (size_t)row * D;
#pragma unroll
            for (int j = 0; j < 8; ++j) {
                f32x4 y[2];
#pragma unroll
                for (int q = 0; q < 2; ++q) { const unsigned bo = 2048u * j + 16u * q + l32; y[q] = v[j][q] * rstd * RP_F4(lg, bo) + RP_F4(lb, bo); }
                if (MODE == 2) { *(GAS f32x4*)((GAS char*)ypf + (2048u * j + l32)) = y[0]; *(GAS f32x4*)((GAS char*)ypf + (2048u * j + 16u + l32)) = y[1]; }
                else {
                    v4u w; w.x = pkbf(y[0].x, y[0].y); w.y = pkbf(y[0].z, y[0].w); w.z = pkbf(y[1].x, y[1].y); w.w = pkbf(y[1].z, y[1].w); *(GAS v4u*)((GAS char*)ypb + (1024u * j + l16)) = w;
                    f32x4 o[2];
#pragma unroll
                    for (int q = 0; q < 2; ++q) { const unsigned bo = 2048u * j + 16u * q + l32; const f32x4 sh = RP_F4(ash, bo) + RP_F4(bsh, bo), sc = RP_F4(asc, bo) + RP_F4(bsc, bo) + 1.0f; o[q] = y[q] * sc + sh; }
                    v4u h; h.x = pkbf(o[0].x, o[0].y); h.y = pkbf(o[0].z, o[0].w); h.z = pkbf(o[1].x, o[1].y); h.w = pkbf(o[1].z, o[1].w); *(GAS v4u*)((GAS char*)hp + (1024u * j + l16)) = h;
                }
                if (j & 1) asm volatile("" ::: "memory");
            }
        }
        if (MODE == 0) {
            const float* ash = ada + (size_t)b * ADAW + seg_sh * D; const float* bsh = bada + seg_sh * D;
            const float* asc = ada + (size_t)b * ADAW + seg_sc * D; const float* bsc = bada + seg_sc * D;
            bf16* hp = H + (size_t)row * D;
#pragma unroll
            for (int j = 0; j < 8; ++j) { f32x4 o[2];
#pragma unroll
                for (int q = 0; q < 2; ++q) { const unsigned bo = 2048u * j + 16u * q + l32; const f32x4 sh = RP_F4(ash, bo) + RP_F4(bsh, bo), sc = RP_F4(asc, bo) + RP_F4(bsc, bo) + 1.0f; o[q] = v[j][q] * sc + sh; }
                v4u w; w.x = pkbf(o[0].x, o[0].y); w.y = pkbf(o[0].z, o[0].w); w.z = pkbf(o[1].x, o[1].y); w.w = pkbf(o[1].z, o[1].w); *(GAS v4u*)((GAS char*)hp + (1024u * j + l16)) = w; if ((j & 3) == 3) asm volatile("" ::: "memory"); }
        }
    }
#undef RP_F4
#undef RP_U4
}

__device__ __forceinline__ void ret_state_unit(int lane, int wave, int bh, int eb, int db, const bf16* KT, const bf16* VT, bf16* RG) {
    const int h = bh & 7, i = lane & 15, g = lane >> 4;
    const int et = eb * 4 + (wave >> 1), dt0 = db * 4 + 2 * (wave & 1);
    const float l2g = pg8::log2_gamma(h);
    const float gam = __builtin_amdgcn_exp2f(l2g), g127 = __builtin_amdgcn_exp2f(127.0f * l2g), g128 = __builtin_amdgcn_exp2f(128.0f * l2g);
    const GAS bf16* KTp = (const GAS bf16*)KT + (size_t)bh * 32 * 32768 + (dt0 * 4) * 512 + lane * 8;
    const GAS bf16* VTp = (const GAS bf16*)VT + (size_t)bh * 32 * 32768 + (et * 4) * 512 + lane * 8;
    GAS bf16* Rp = (GAS bf16*)RG + (size_t)bh * 32 * 65536;
    int roff[2];
#pragma unroll
    for (int t = 0; t < 2; ++t) roff[t] = pg8::frag_off(16 * et + i, 16 * (dt0 + t) + 4 * g, 8);
    f32x4 st[2]; st[0] = (f32x4){0.f, 0.f, 0.f, 0.f}; st[1] = st[0];
    bf16x8 vf[3][4], kt[3][2][4];
#define RS_LOAD(cc, sl) do { const int tn_ = ((cc) < SEQ / CHK ? (cc) : SEQ / CHK - 1) * 32768; \
        _Pragma("unroll") for (int s = 0; s < 4; ++s) vf[sl][s] = *(const GAS bf16x8*)(VTp + tn_ + s * 512); \
        _Pragma("unroll") for (int t = 0; t < 2; ++t) _Pragma("unroll") for (int s = 0; s < 4; ++s) kt[sl][t][s] = *(const GAS bf16x8*)(KTp + tn_ + (t * 4 + s) * 512); } while (0)
    RS_LOAD(0, 0); RS_LOAD(1, 1);
    for (int c3 = 0; c3 < SEQ / CHK; c3 += 3) {
#pragma unroll
        for (int u = 0; u < 3; ++u) {
            const int c = c3 + u;
            if (c >= SEQ / CHK) break;
            RS_LOAD(c + 2, (u + 2) % 3);
#pragma unroll
            for (int t = 0; t < 2; ++t) {
                u32x2 w; w.x = pkbf(gam * st[t][0], gam * st[t][1]); w.y = pkbf(gam * st[t][2], gam * st[t][3]);
                *(GAS u32x2*)(Rp + (size_t)c * 65536 + roff[t]) = w;
                f32x4 tmp = (f32x4){0.f, 0.f, 0.f, 0.f};
#pragma unroll
                for (int s = 0; s < 4; ++s) tmp = MFMA16(kt[u][t][s], vf[u][s], tmp);
                st[t] = st[t] * g128 + tmp * g127;
            }
        }
    }
#undef RS_LOAD
}
__device__ __forceinline__ void ret_out_unit(LAS unsigned char* lds, int tid, int lane, int wave, int bh, int c, const bf16* Q, const bf16* K, const bf16* VT, const bf16* RG, const bf16* GS, bf16* RETG) {
    constexpr int KQ_OFF = 0, KQ_PITCH = 528, PL_OFF = 128 * KQ_PITCH, PL_PITCH = 272, ST_OFF = PL_OFF + 128 * PL_PITCH;
    static_assert(ST_OFF + 128 * 8 * 8 <= RING_BYTES, "retention LDS");
    const int b = bh >> 3, h = bh & 7, i = lane & 15, g = lane >> 4, rb = wave, tok0 = b * SEQ + c * CHK;
    const GAS bf16* Qp = (const GAS bf16*)Q + (size_t)tok0 * RW + 256 * h;
    const GAS bf16* Kp = (const GAS bf16*)K + (size_t)tok0 * RW + 256 * h;
    v4u kreg[8];
#pragma unroll
    for (int q = 0; q < 8; ++q) { const int idx = tid + 512 * q, row = idx >> 5, c16 = idx & 31; kreg[q] = *(const GAS v4u*)(Kp + (size_t)row * RW + c16 * 8); }
    bf16x8 qf[8];
#pragma unroll
    for (int s = 0; s < 8; ++s) qf[s] = *(const GAS bf16x8*)(Qp + (size_t)(16 * rb + i) * RW + 32 * s + 8 * g);
#pragma unroll
    for (int q = 0; q < 8; ++q) { const int idx = tid + 512 * q, row = idx >> 5, c16 = idx & 31; *(LAS v4u*)(lds + KQ_OFF + row * KQ_PITCH + c16 * 16) = kreg[q]; }
    __syncthreads();
#pragma unroll
    for (int q = 0; q < 8; ++q) { const int idx = tid + 512 * q, row = idx >> 5, c16 = idx & 31; kreg[q] = *(const GAS v4u*)(Qp + (size_t)row * RW + c16 * 8); }
    bf16x8 vf[2][4], rf[2][8];
    {
        const GAS bf16* VTp = (const GAS bf16*)VT + ((size_t)bh * 32 + c) * 32768 + (2 * wave * 4) * 512 + lane * 8;
        const GAS bf16* RGp = (const GAS bf16*)RG + ((size_t)bh * 32 + c) * 65536 + (2 * wave * 8) * 512 + lane * 8;
#pragma unroll
        for (int t = 0; t < 2; ++t) {
#pragma unroll
            for (int s = 0; s < 4; ++s) vf[t][s] = *(const GAS bf16x8*)(VTp + (t * 4 + s) * 512);
#pragma unroll
            for (int s = 0; s < 8; ++s) rf[t][s] = *(const GAS bf16x8*)(RGp + (t * 8 + s) * 512);
        }
    }
    for (int j = 0; j <= rb; ++j) {
        f32x4 acc = (f32x4){0.f, 0.f, 0.f, 0.f};
#pragma unroll
        for (int s = 0; s < 8; ++s) { const bf16x8 a = *(const LAS bf16x8*)(lds + KQ_OFF + (16 * j + i) * KQ_PITCH + (32 * s + 8 * g) * 2); acc = MFMA16(a, qf[s], acc); }
        if (j == rb) {
#pragma unroll
            for (int r = 0; r < 4; ++r) if (4 * g + r > i) acc[r] = 0.f;
        }
        u32x2 w; w.x = pkbf(acc[0], acc[1]); w.y = pkbf(acc[2], acc[3]);
        *(LAS u32x2*)(lds + PL_OFF + (16 * rb + i) * PL_PITCH + (16 * j + 4 * g) * 2) = w;
    }
    if ((rb & 1) == 0) { u32x2 z; z.x = 0u; z.y = 0u; *(LAS u32x2*)(lds + PL_OFF + (16 * rb + i) * PL_PITCH + (16 * (rb + 1) + 4 * g) * 2) = z; }
    __syncthreads();
#pragma unroll
    for (int q = 0; q < 8; ++q) { const int idx = tid + 512 * q, row = idx >> 5, c16 = idx & 31; *(LAS v4u*)(lds + KQ_OFF + row * KQ_PITCH + c16 * 16) = kreg[q]; }
    __syncthreads();
    f32x4 o[8][2];
#pragma unroll
    for (int nb = 0; nb < 8; ++nb) {
        o[nb][0] = (f32x4){0.f, 0.f, 0.f, 0.f}; o[nb][1] = o[nb][0];
#pragma unroll
        for (int s = 0; s < 4; ++s) if (s <= (nb >> 1)) {
            const bf16x8 p = *(const LAS bf16x8*)(lds + PL_OFF + (16 * nb + i) * PL_PITCH + (32 * s + 8 * g) * 2);
            o[nb][0] = MFMA16(vf[0][s], p, o[nb][0]); o[nb][1] = MFMA16(vf[1][s], p, o[nb][1]); }
#pragma unroll
        for (int s = 0; s < 8; ++s) {
            const bf16x8 qq = *(const LAS bf16x8*)(lds + KQ_OFF + (16 * nb + i) * KQ_PITCH + (32 * s + 8 * g) * 2);
            o[nb][0] = MFMA16(rf[0][s], qq, o[nb][0]); o[nb][1] = MFMA16(rf[1][s], qq, o[nb][1]); }
    }
    LAS f32x2* ST = (LAS f32x2*)(lds + ST_OFF);
#pragma unroll
    for (int nb = 0; nb < 8; ++nb) {
        float s1 = 0.f, s2 = 0.f;
#pragma unroll
        for (int t = 0; t < 2; ++t)
#pragma unroll
            for (int r = 0; r < 4; ++r) { const float v = o[nb][t][r]; s1 += v; s2 += v * v; }
        s1 += __shfl_xor(s1, 16); s1 += __shfl_xor(s1, 32); s2 += __shfl_xor(s2, 16); s2 += __shfl_xor(s2, 32);
        if (g == 0) { f32x2 v; v.x = s1; v.y = s2; ST[(16 * nb + i) * 8 + wave] = v; }
    }
    __syncthreads();
#pragma unroll
    for (int nb = 0; nb < 8; ++nb) {
        float s1 = 0.f, s2 = 0.f;
#pragma unroll
        for (int w = 0; w < 8; ++w) { const f32x2 v = ST[(16 * nb + i) * 8 + w]; s1 += v.x; s2 += v.y; }
        const float mean = s1 * (1.f / HD), var = fmaxf(s2 * (1.f / HD) - mean * mean, 0.f), rstd = 1.0f / sqrtf(var + LN_EPS);
        const size_t rowoff = (size_t)(tok0 + 16 * nb + i) * RW + 256 * h + 32 * wave + 4 * g, outoff = (size_t)(tok0 + 16 * nb + i) * (2 * RW) + 256 * h + 32 * wave + 4 * g;
#pragma unroll
        for (int t = 0; t < 2; ++t) {
            const u32x2 gwv = *(const GAS u32x2*)(GS + rowoff + 16 * t);
            const f32x4 y = (o[nb][t] - mean) * rstd * (f32x4){bflo(gwv.x), bfhi(gwv.x), bflo(gwv.y), bfhi(gwv.y)};
            u32x2 w; w.x = pkbf(y[0], y[1]); w.y = pkbf(y[2], y[3]); *(GAS u32x2*)(RETG + outoff + 16 * t) = w;
        }
    }
    __syncthreads();
}

__device__ __forceinline__ void sg_unit(LAS unsigned char* lds, int tid, int lane, int wave, int ck, int grp, const float* sgw, const float* sgb, const float* lng, const float* lnb,
                                        const float* stats, const bf16* ST, const bf16* UG, bf16* SGU) {
    constexpr int WL_OFF = 0, WL_PITCH = 272, MU_OFF = 128 * WL_PITCH, RS_OFF = MU_OFF + 512, C1_OFF = RS_OFF + 512, C2_OFF = C1_OFF + 512, BS_OFF = C2_OFF + 512;
    const int tok0 = ck * CHK;
    LAS float* MU = (LAS float*)(lds + MU_OFF); LAS float* RS = (LAS float*)(lds + RS_OFF); LAS float* C1 = (LAS float*)(lds + C1_OFF); LAS float* C2 = (LAS float*)(lds + C2_OFF); LAS float* BS = (LAS float*)(lds + BS_OFF);
    if (tid < CHK) {
        const GAS f32x2* sp = (const GAS f32x2*)(stats + (size_t)(tok0 + tid) * 64); float s = 0.f, q = 0.f;
#pragma unroll 8
        for (int p = 0; p < 32; ++p) { const f32x2 v = sp[p]; s += v.x; q += v.y; }
        const float mean = s * (1.f / SGW), var = fmaxf(q * (1.f / SGW) - mean * mean, 0.f);
        MU[tid] = mean; RS[tid] = 1.0f / sqrtf(var + LN_EPS);
    }
    __syncthreads();
    {
        const int t = tid >> 2, sq = tid & 3; const GAS float* wrow = (const GAS float*)sgw + ((size_t)grp * CHK + t) * CHK + 32 * sq;
        float c1 = 0.f, c2 = 0.f;
#pragma unroll
        for (int j = 0; j < 32; j += 2) { const int s = 32 * sq + j; const float w0 = (s <= t) ? wrow[j] : 0.f, w1 = (s + 1 <= t) ? wrow[j + 1] : 0.f;
            const float a0 = w0 * RS[s], a1 = w1 * RS[s + 1]; c2 += w0 + w1; c1 += a0 * MU[s] + a1 * MU[s + 1];
            *(LAS unsigned*)(lds + WL_OFF + t * WL_PITCH + s * 2) = pkbf(a0, a1); }
        c1 += __shfl_xor(c1, 1); c1 += __shfl_xor(c1, 2); c2 += __shfl_xor(c2, 1); c2 += __shfl_xor(c2, 2);
        if (sq == 0) { C1[t] = c1; C2[t] = c2; BS[t] = sgb[grp * CHK + t]; }
    }
    __syncthreads();
    const int i = lane & 15, g = lane >> 4, trow = 16 * wave + i, nsteps = (wave >> 1) + 1;
    bf16x8 wf[4];
#pragma unroll
    for (int s = 0; s < 4; ++s) wf[s] = *(const LAS bf16x8*)(lds + WL_OFF + trow * WL_PITCH + (32 * s + 8 * g) * 2);
    const float c1t = C1[trow], c2t = C2[trow], bst = BS[trow];
    bf16x8 af[3][4]; f32x4 lgv[3], lbv[3]; u32x2 uwv[3];
    const GAS bf16* spb = (const GAS bf16*)ST + (size_t)ck * 262144 + (16 * grp * 4) * 512 + lane * 8;
    const int chb = GD * grp + 4 * g;
    const GAS bf16* ugp = (const GAS bf16*)UG + (size_t)(tok0 + trow) * SGW + chb;
    GAS bf16* sgp = (GAS bf16*)SGU + (size_t)(tok0 + trow) * (2 * SGW) + chb;
#define SG_LOAD(j, sl) do { _Pragma("unroll") for (int s = 0; s < 4; ++s) if (s < nsteps) af[sl][s] = *(const GAS bf16x8*)(spb + ((j) * 4 + s) * 512); \
        lgv[sl] = *(const GAS f32x4*)(lng + chb + 16 * (j)); lbv[sl] = *(const GAS f32x4*)(lnb + chb + 16 * (j)); uwv[sl] = *(const GAS u32x2*)(ugp + 16 * (j)); } while (0)
    SG_LOAD(0, 0); SG_LOAD(1, 1);
#pragma unroll
    for (int j = 0; j < 16; ++j) {
        if (j + 2 < 16) SG_LOAD(j + 2, (j + 2) % 3);
        const int sl = j % 3;
        f32x4 acc = (f32x4){0.f, 0.f, 0.f, 0.f};
#pragma unroll
        for (int s = 0; s < 4; ++s) if (s < nsteps) acc = MFMA16(af[sl][s], wf[s], acc);
        const f32x4 uv = (f32x4){bflo(uwv[sl].x), bfhi(uwv[sl].x), bflo(uwv[sl].y), bfhi(uwv[sl].y)};
        const f32x4 val = uv * (lgv[sl] * (acc - c1t) + lbv[sl] * c2t + bst);
        u32x2 w; w.x = pkbf(val[0], val[1]); w.y = pkbf(val[2], val[3]);
        *(GAS u32x2*)(sgp + 16 * j) = w;
    }
#undef SG_LOAD
    __syncthreads();
}

__global__ void __launch_bounds__(NWAVES * 64, 2) fwd(Args args) {
    extern __shared__ __attribute__((aligned(16))) unsigned char lds_raw[];
    LAS unsigned char* lds = (LAS unsigned char*)lds_raw;
    volatile LAS unsigned* MISC = (volatile LAS unsigned*)(lds + MISC_OFF);
    const int tid = threadIdx.x, lane = tid & 63, wave = __builtin_amdgcn_readfirstlane(tid >> 6);
    const int G = gridDim.x, bx = blockIdx.x, vcu = (G % 8 == 0) ? (bx % 8) * (G / 8) + bx / 8 : bx;
    const int gw = vcu * NWAVES + wave, NGW = G * NWAVES;
    unsigned char* ws = args.ws;
    unsigned* ctl = (unsigned*)(ws + WS_CTL);
    const float* x = args.in[0]; const float* cin = args.in[1]; const int* pos = (const int*)args.in[2]; const float* w_ada = args.in[3]; const float* b_ada = args.in[4];
    const float* w_in = args.in[5]; const float* sg_ln_g = args.in[6]; const float* sg_ln_b = args.in[7]; const float* sg_w = args.in[8]; const float* sg_b = args.in[9];
    const float* w_ret_up = args.in[10]; const float* w_sg_up = args.in[11]; const float* w_out = args.in[12]; const float* ln1_g = args.in[13]; const float* ln1_b = args.in[14];
    const float* w_gate_up = args.in[15]; const float* w_down = args.in[16]; const float* ln2_g = args.in[17]; const float* ln2_b = args.in[18];
    float* ada = (float*)(ctl + CW_ADA);
    float* cosT = (float*)(ws + WS_COS); float* sinT = (float*)(ws + WS_SIN); float* stats = (float*)(ws + WS_STATS);
    bf16 *WIN = (bf16*)(ws + WS_WIN), *WRET = (bf16*)(ws + WS_WRET), *WSG = (bf16*)(ws + WS_WSG), *WOUT = (bf16*)(ws + WS_WOUT), *WGU = (bf16*)(ws + WS_WGU), *WDN = (bf16*)(ws + WS_WDN);
    bf16 *H = (bf16*)(ws + WS_H), *Qb = (bf16*)(ws + WS_Q), *Kb = (bf16*)(ws + WS_K), *KTb = (bf16*)(ws + WS_KT), *VTb = (bf16*)(ws + WS_VT), *GSb = (bf16*)(ws + WS_GS), *UGb = (bf16*)(ws + WS_UG), *STb = (bf16*)(ws + WS_ST);
    bf16 *SIGR = (bf16*)(ws + WS_SIGR), *SIGS = (bf16*)(ws + WS_SIGS), *RETG = (bf16*)(ws + WS_RETG), *SGU = (bf16*)(ws + WS_RETG) + RW, *MIX = (bf16*)(ws + WS_MIX), *ACT = (bf16*)(ws + WS_ACT);
    bf16* RGb = (bf16*)(ws + WS_RET);
    float* PRE = (float*)(ws + WS_PRE);
    bf16 *PREb = (bf16*)(ws + WS_X1), *X1b = (bf16*)(ws + WS_X1 + 64 * MiB);

    for (int u = tid; u < (LDS_BYTES - LDSCTL_OFF) / 4; u += NWAVES * 64) ((LAS unsigned*)(lds + LDSCTL_OFF))[u] = 0u;
    __syncthreads();
    XcdBarrier bar; bar.bar = ctl + CW_BAR; bar.x = 0; bar.st = nullptr;
    if (MK_N_LAUNCHES == 1) bar = xcd_barrier_post(ctl + CW_BAR, MISC + 8);
    const int lo = args.ph_lo, hi = args.ph_hi;
#if defined(GP_STAMP) || defined(PH_STAMP)
    unsigned long long* prb = (unsigned long long*)(ctl + 32768);
    unsigned long long gp_prev = __builtin_amdgcn_s_memrealtime(); const unsigned long long gp_t0 = gp_prev;
#define PSTAMP(k) do { if (bx == 0 && tid == 0) { const unsigned long long now_ = __builtin_amdgcn_s_memrealtime(); prb[64 + (k)] = now_ - gp_prev; gp_prev = now_; } } while (0)
#ifdef GP_STAMP
#define SPRB(k) S.prb = prb + 4 * (k);
#else
#define SPRB(k)
#endif
#else
#define PSTAMP(k) do {} while (0)
#define SPRB(k)
#endif
#ifndef PH_MASK
#ifdef DBG_STOP
#define PH_MASK (((2u << DBG_STOP) - 1u) | 0x800u)
#else
#define PH_MASK 0xfff
#endif
#endif
#define IN(k) (((PH_MASK >> (k)) & 1) && lo <= (k) && (k) < hi)
#define SEAM(k) do { if (IN(k) && IN((k) + 1)) xcd_barrier(bar); PSTAMP(k); } while (0)
#ifndef DUP_MASK
#define DUP_MASK 0
#endif
#define REP(k) for (int rep_ = 0; rep_ < (((DUP_MASK >> (k)) & 1) ? 2 : 1); ++rep_)

    if (IN(0)) REP(0) {
        LAS float* scl = (LAS float*)(lds + RING_OFF);
        for (int u = tid; u < BATCH * D; u += NWAVES * 64) { const float v = cin[u]; scl[u] = v / (1.0f + expf(-v)); }
        __syncthreads();
#ifndef DUP_P0
#define DUP_P0 0
#endif
        for (int rr0 = 0; rr0 < ((DUP_P0 & 1) ? 2 : 1); ++rr0)
        for (int cb = vcu; cb < ADAW / 96; cb += G) {
            const int half = lane / 24, c4 = lane - 24 * half;
            f32x4 a0 = (f32x4){0.f, 0.f, 0.f, 0.f}, a1 = a0;
            if (lane < 48) {
                const GAS float* wp = (const GAS float*)w_ada + (size_t)(512 * wave + half) * ADAW + cb * 96 + 4 * c4;
#pragma unroll 8
                for (int kk = 0; kk < 256; ++kk) { const f32x4 w = *(const GAS f32x4*)(wp + (size_t)(2 * kk) * ADAW); const int k = 512 * wave + 2 * kk + half; const float s0 = scl[k], s1 = scl[D + k]; a0 += w * s0; a1 += w * s1; }
            }
            LAS f32x4* red = (LAS f32x4*)(lds + RING_OFF + 32768);
            if (lane < 48) { red[(wave * 48 + lane) * 2] = a0; red[(wave * 48 + lane) * 2 + 1] = a1; }
            __syncthreads();
            if (tid < 48) {
                const int bsel = tid / 24, cc = tid - 24 * bsel; f32x4 s = (f32x4){0.f, 0.f, 0.f, 0.f};
#pragma unroll
                for (int w = 0; w < 8; ++w) { s += red[(w * 48 + cc) * 2 + bsel]; s += red[(w * 48 + 24 + cc) * 2 + bsel]; }
                *(GAS f32x4*)(ada + (size_t)bsel * ADAW + cb * 96 + 4 * cc) = s;
            }
            __syncthreads();
        }
        for (int rr1 = 0; rr1 < ((DUP_P0 & 2) ? 2 : 1); ++rr1)
        {
            constexpr int I0 = (D / 64) * (INW / 64), I1 = (RW / 64) * (D / 64), I2 = I1, I3 = (D / 64) * (D / 64), I4 = (D / 64) * (2 * DFF / 64), I5 = (DFF / 64) * (D / 64);
            constexpr int NIT = I0 + I1 + I2 + I3 + I4 + I5;
            for (int it = gw; it < NIT; it += NGW) {
                int r = it;
#ifdef TR_NFAST
#define TR_KB(r, KB, NB) ((r) / (NB))
#define TR_NB(r, KB, NB) ((r) % (NB))
#else
#define TR_KB(r, KB, NB) ((r) % (KB))
#define TR_NB(r, KB, NB) ((r) / (KB))
#endif
                if (r < I0) { const int kb = TR_KB(r, D / 64, INW / 64), n0 = TR_NB(r, D / 64, INW / 64) * 64; p0_transpose_item(w_in, D, INW, WIN, kb, n0, n0, lane); continue; } r -= I0;
                if (r < I1) { const int kb = TR_KB(r, RW / 64, D / 64), n0 = TR_NB(r, RW / 64, D / 64) * 64; p0_transpose_item(w_ret_up, RW, D, WRET, kb, n0, n0, lane, 2 * RW, 0); continue; }   r -= I1;
                if (r < I2) { const int kb = TR_KB(r, SGW / 64, D / 64), n0 = TR_NB(r, SGW / 64, D / 64) * 64; p0_transpose_item(w_sg_up, SGW, D, WRET, kb, n0, n0, lane, 2 * RW, RW); continue; } r -= I2;
                if (r < I3) { const int kb = TR_KB(r, D / 64, D / 64), n0 = TR_NB(r, D / 64, D / 64) * 64; p0_transpose_item(w_out, D, D, WOUT, kb, n0, n0, lane); continue; } r -= I3;
                if (r < I4) { const int kb = TR_KB(r, D / 64, 2 * DFF / 64), n0 = TR_NB(r, D / 64, 2 * DFF / 64) * 64; p0_transpose_item(w_gate_up, D, 2 * DFF, WGU, kb, n0, gu_row0(n0), lane); continue; } r -= I4;
                { const int kb = TR_KB(r, DFF / 64, D / 64), n0 = TR_NB(r, DFF / 64, D / 64) * 64; p0_transpose_item(w_down, DFF, D, WDN, kb, n0, n0, lane); }
            }
        }
        for (int rr2 = 0; rr2 < ((DUP_P0 & 4) ? 2 : 1); ++rr2)
        for (int e = (vcu * NWAVES * 64 + tid); e < M * 128; e += G * NWAVES * 64) {
            const int row = e >> 7, j = e & 127;
            const float inv = (float)exp2(-(double)j * (13.287712379549449 / 128.0));
            const float angf = (float)pos[row] * inv;
            const double a = (double)angf; const double rr = a - 6.283185307179586476925 * rint(a * 0.15915494309189533577);
            cosT[e] = cosf((float)rr); sinT[e] = sinf((float)rr);
        }
        __syncthreads();
    }
    SEAM(0);
    if (IN(1)) REP(1) row_pass<0>(gw, NGW, lane, x, nullptr, nullptr, nullptr, nullptr, H, ada, b_ada, 0, 1);
    SEAM(1);
    if (IN(2)) REP(2) {
        pg8::Gemm g{H, WIN, M, INW, D}; pg8::StaticOrder S; S.init(M, INW, G, bx); SPRB(2)
        pg8::EpiZ E{ws, stats, cosT, sinT};
        pg8::gemm_phase<pg8::EpiZ, pg8::StaticOrder, true, true>(lds + RING_OFF, g, S, E);
    }
    SEAM(2);
    if (IN(3)) REP(3) {
#ifndef DUP_SUB
#define DUP_SUB 0
#endif
        for (int rr = 0; rr < ((DUP_SUB & 1) ? 2 : 1); ++rr)
        for (int u0 = vcu; u0 < 256; u0 += G) { const int uid = (u0 + 100 * rr) & 255; ret_state_unit(lane, wave, uid >> 4, (uid >> 2) & 3, uid & 3, KTb, VTb, RGb); }
        for (int rr = 0; rr < ((DUP_SUB & 2) ? 2 : 1); ++rr)
        for (int u0 = vcu; u0 < 512; u0 += G) { const int uid = (u0 + 200 * rr) & 511; sg_unit(lds + RING_OFF, tid, lane, wave, uid >> 3, uid & 7, sg_w, sg_b, sg_ln_g, sg_ln_b, stats, STb, UGb, SGU); }
    }
    SEAM(3);
    if (IN(4)) REP(4) {
        for (int u0 = vcu; u0 < 512; u0 += G) { const int uid = (u0 + 200 * rep_) & 511; ret_out_unit(lds + RING_OFF, tid, lane, wave, uid >> 5, uid & 31, Qb, Kb, VTb, RGb, GSb, RETG); }
    }
    SEAM(4);
    if (IN(5)) REP(5) {
        pg8::Gemm g{RETG, WRET, M, D, 2 * RW}; pg8::StaticOrder S; S.init(M, D, G, bx); SPRB(5)
        pg8::EpiMixCat E{SIGR, SIGS, MIX, D};
        pg8::gemm_phase<pg8::EpiMixCat, pg8::StaticOrder, true, true>(lds + RING_OFF, g, S, E);
    }
    SEAM(5);
    if (IN(7)) REP(7) {
        pg8::Gemm g{MIX, WOUT, M, D, D}; pg8::StaticOrder S; S.init(M, D, G, bx); SPRB(7)
        pg8::EpiRes<false> E{x, PREb, D, ada + 2 * D, b_ada + 2 * D, ADAW, SEQ, ALPHA};
        pg8::gemm_phase<pg8::EpiRes<false>, pg8::StaticOrder, true, true>(lds + RING_OFF, g, S, E);
    }
    SEAM(7);
    if (IN(8)) REP(8) row_pass<1>(gw, NGW, lane, PREb, ln1_g, ln1_b, nullptr, X1b, H, ada, b_ada, 3, 4);
    SEAM(8);
#ifdef PROBE_NULL9
    if (IN(9)) {
        pg8::Gemm g{H, WGU, M, 2 * DFF, D}; pg8::StaticOrder S; S.init(M, 2 * DFF, G, bx);
        pg8::EpiNull E{(float*)(ws + WS_STATS)};
        pg8::gemm_phase<pg8::EpiNull, pg8::StaticOrder, true, true>(lds + RING_OFF, g, S, E);
    }
#endif
    if (IN(9)) REP(9) {
        pg8::Gemm g{H, WGU, M, 2 * DFF, D}; pg8::StaticOrder S; S.init(M, 2 * DFF, G, bx); SPRB(9)
        pg8::EpiSwiGLU E{ACT, DFF};
        pg8::gemm_phase<pg8::EpiSwiGLU, pg8::StaticOrder, true, true>(lds + RING_OFF, g, S, E);
    }
    SEAM(9);
    if (IN(10)) REP(10) {
        pg8::Gemm g{ACT, WDN, M, D, DFF}; pg8::StaticOrder S; S.init(M, D, G, bx); SPRB(10)
        pg8::EpiRes<true> E{X1b, PREb, D, ada + 5 * D, b_ada + 5 * D, ADAW, SEQ, ALPHA};
        pg8::gemm_phase<pg8::EpiRes<true>, pg8::StaticOrder, true, true>(lds + RING_OFF, g, S, E);
    }
    SEAM(10);
#ifndef DBG_STOP
    if (IN(11)) REP(11) row_pass<2>(gw, NGW, lane, PREb, ln2_g, ln2_b, args.out, nullptr, nullptr, nullptr, nullptr, 0, 0);
#else
    if (IN(11)) {
        const size_t NT = (size_t)G * NWAVES * 64, NE = (size_t)M * D, HN = (size_t)M * 2048;
        for (size_t e = (size_t)vcu * NWAVES * 64 + tid; e < NE; e += NT) {
            float s = 0.f; const size_t eh = e % HN;
            if (DBG_STOP == 1) { s = bflo((unsigned)H[e]) ; }
            if (DBG_STOP == 0) { s = bflo((unsigned)WIN[e]) + bflo((unsigned)WIN[e + NE]) + bflo((unsigned)WGU[e]) + bflo((unsigned)WGU[e + NE]) + bflo((unsigned)WDN[e]) + bflo((unsigned)WOUT[e % ((size_t)D * D)]) + bflo((unsigned)WRET[eh % ((size_t)D * RW)]) + bflo((unsigned)WSG[eh % ((size_t)D * RW)]) + cosT[e % ((size_t)M * 128)] + sinT[e % ((size_t)M * 128)] + ada[e % (2 * ADAW)]; }
            if (DBG_STOP == 2) { s = bflo((unsigned)Qb[eh]) + bflo((unsigned)Kb[eh]) + bflo((unsigned)KTb[eh]) + bflo((unsigned)VTb[eh]) + bflo((unsigned)GSb[eh]) + bflo((unsigned)UGb[eh]) + bflo((unsigned)STb[eh]) + bflo((unsigned)SIGR[e]) + bflo((unsigned)SIGS[e]) + stats[e % ((size_t)M * 64)]; }
#ifndef DBG_P3
#define DBG_P3 3
#endif
            if (DBG_STOP == 3) { s = ((DBG_P3 & 1) ? bflo((unsigned)RGb[e]) : 0.f) + ((DBG_P3 & 2) ? bflo((unsigned)RETG[e]) : 0.f); }
            if (DBG_STOP == 4) { s = bflo((unsigned)RETG[e]); }
            if (DBG_STOP == 6) { s = bflo((unsigned)MIX[e]); }
            if (DBG_STOP == 7) { s = bflo((unsigned)PREb[e]); }
            if (DBG_STOP == 8) { s = bflo((unsigned)X1b[e]) + bflo((unsigned)H[e]); }
            if (DBG_STOP == 9) { s = bflo((unsigned)ACT[e]) + bflo((unsigned)ACT[e + NE]); }
            if (DBG_STOP == 10) { s = bflo((unsigned)PREb[e]); }
            args.out[e] = s;
        }
    }
#endif
#if defined(GP_STAMP) || defined(PH_STAMP)
    PSTAMP(11);
    if (bx == 0 && tid == 0) prb[80] = __builtin_amdgcn_s_memrealtime() - gp_t0;
    if (bx == 0 && tid == 0 && IN(11)) { const unsigned long long t_end = __builtin_amdgcn_s_memrealtime() + (unsigned long long)PRB_AMP * prb[PRB_A];
        while (__builtin_amdgcn_s_memrealtime() < t_end) __builtin_amdgcn_s_sleep(16); }
#endif
#undef IN
#undef SEAM
}

extern "C" void kernel_launch(void* const* d_in, const int* in_sizes, int n_in, void* d_out, int out_size, void* d_ws, size_t ws_size, hipStream_t stream) {
    static int grid = 0;
    if (grid == 0) {
        if (n_in != 19 || in_sizes[0] != M * D || out_size != M * D || ws_size < WS_END) { fprintf(stderr, "kernel_launch: unexpected shapes (n_in %d, in0 %d, out %d, ws %zu)\n", n_in, n_in > 0 ? in_sizes[0] : -1, out_size, ws_size); grid = -1; return; }
        int dev = 0, cus = 0, per_cu = 0;
        if (hipGetDevice(&dev) != hipSuccess || hipDeviceGetAttribute(&cus, hipDeviceAttributeMultiprocessorCount, dev) != hipSuccess) { grid = -1; return; }
        if (hipFuncSetAttribute((const void*)fwd, hipFuncAttributeMaxDynamicSharedMemorySize, LDS_BYTES) != hipSuccess) { fprintf(stderr, "kernel_launch: hipFuncSetAttribute failed\n"); grid = -1; return; }
        if (hipOccupancyMaxActiveBlocksPerMultiprocessor(&per_cu, (const void*)fwd, NWAVES * 64, LDS_BYTES) != hipSuccess || per_cu < 1) fprintf(stderr, "kernel_launch: occupancy query reports %d\n", per_cu);
        (void)hipGetLastError();
        grid = cus;
    }
    if (grid < 0) return;
    if (hipMemsetAsync((char*)d_ws + WS_CTL, 0, CTL_ZERO_BYTES, stream) != hipSuccess) { fprintf(stderr, "kernel_launch: memset failed\n"); return; }
    Args a{};
    for (int i = 0; i < 19; ++i) a.in[i] = (const float*)d_in[i];
    a.out = (float*)d_out; a.ws = (unsigned char*)d_ws;
    if (MK_N_LAUNCHES == 1) { a.ph_lo = 0; a.ph_hi = N_PHASES + 1; hipLaunchKernelGGL(fwd, dim3(grid), dim3(NWAVES * 64), LDS_BYTES, stream, a); }
    else for (int p = 0; p <= N_PHASES; ++p) { a.ph_lo = p; a.ph_hi = p + 1; hipLaunchKernelGGL(fwd, dim3(grid), dim3(NWAVES * 64), LDS_BYTES, stream, a); }
    const hipError_t le = hipPeekAtLastError();
    if (le != hipSuccess) fprintf(stderr, "kernel_launch: launch failed: %s\n", hipGetErrorName(le));
}
```

```cpp
#include <hip/hip_runtime.h>
#include <cstdio>
#include <cstdint>
constexpr int NWAVES = 8;
constexpr int BATCH = 2, SEQ = 4096, D = 4096, M = BATCH * SEQ;
constexpr int RW = 2048, NH = 8, HD = 256, SGW = 2048, NG = 8, GD = 256, CHK = 128, DFF = 11008, INW = 20480, ADAW = 6 * D;
constexpr float LN_EPS = 1e-5f;
constexpr float ALPHA = 1.189207115002721f;
#ifndef MK_N_LAUNCHES
#define MK_N_LAUNCHES 1
#endif
constexpr int N_PHASES = 11;

constexpr size_t MiB = 1u << 20;
constexpr size_t WS_CTL = 0, CTL_ZERO_BYTES = 1 * MiB;
constexpr size_t WS_COS = 1 * MiB, WS_SIN = 5 * MiB, WS_STATS = 9 * MiB;
constexpr size_t WS_WIN = 16 * MiB, WS_WRET = 176 * MiB, WS_WSG = 192 * MiB, WS_WOUT = 208 * MiB, WS_WGU = 240 * MiB, WS_WDN = 412 * MiB;
constexpr size_t WS_H = 498 * MiB, WS_Q = 562 * MiB, WS_K = 594 * MiB, WS_KT = 626 * MiB, WS_VT = 658 * MiB, WS_GS = 690 * MiB, WS_UG = 722 * MiB, WS_ST = 754 * MiB;
constexpr size_t WS_SIGR = 786 * MiB, WS_SIGS = 850 * MiB, WS_RET = 914 * MiB, WS_RETG = 978 * MiB, WS_SGU = 1010 * MiB, WS_MIX = 1042 * MiB, WS_PRE = 1106 * MiB, WS_X1 = 1234 * MiB;
constexpr size_t WS_ACT = 562 * MiB;
constexpr size_t WS_END = 1362 * MiB;
static_assert(WS_WGU + (size_t)2 * DFF * D * 2 <= WS_WDN && WS_WDN + (size_t)D * DFF * 2 <= WS_H && WS_ACT + (size_t)M * DFF * 2 <= WS_ST, "d_ws map");
constexpr int CW_BAR = 4096;
constexpr int CW_WQ = 16384;
constexpr int CW_ADA = 65536;
static_assert((CW_ADA + 2 * ADAW) * 4 <= (int)CTL_ZERO_BYTES, "ctl");

constexpr int RING_OFF = 0, RING_BYTES = 131072;
constexpr int LDSCTL_OFF = RING_BYTES, MISC_OFF = LDSCTL_OFF + 320;
constexpr int LDS_BYTES = 147456;

namespace pg8 {
#define PG8_LAS __attribute__((address_space(3)))
typedef unsigned short bf16_t;
typedef short bf16x8 __attribute__((ext_vector_type(8)));
typedef float f32x4 __attribute__((ext_vector_type(4)));
typedef unsigned u32x4 __attribute__((ext_vector_type(4)));
constexpr int BM = 256, BK = 64, HALF = 128, HTB = HALF * BK * 2  , STAGE_BYTES = 8 * HTB, NXCD = 8, WGM = 8;

__host__ __device__ __forceinline__ int lds_byte(int r, int c) { const int st = (r >> 4) * 2 + (c >> 5), rr = r & 15, cc = c & 31, ob = rr * 64 + cc * 2; return st * 1024 + (ob ^ (((ob >> 9) & 1) << 5)); }
__host__ __device__ __forceinline__ void stage_rc(int b, int& R, int& C) { const int st = b / 1024, sb = b % 1024, swz = sb ^ (((sb >> 9) & 1) << 5); R = (st >> 1) * 16 + swz / 64; C = (st & 1) * 32 + (swz % 64) / 2; }
__host__ __device__ __forceinline__ int perm32(int rho) { const int n = rho >> 4, i = rho & 15; return 8 * (i >> 2) + 4 * n + (i & 3); }

struct Unit { int pm, pn; };
struct Gemm { const bf16_t* A; const bf16_t* Bt; int M, N, K; };

struct StaticOrder {
    int nM, nN, nwg, G, c; unsigned long long* prb = nullptr;
    __host__ __device__ void init(int M, int N, int G_, int c_) { nM = M / BM; nN = N / BM; nwg = nM * nN; G = G_; c = c_; }
    __host__ __device__ bool next(int i, Unit& u) const {
        const long L = (long)i * G + c; if (L >= nwg) return false;
        int wgid = (int)L; { const int q = nwg / NXCD, r = nwg % NXCD, xcd = wgid % NXCD, off = wgid / NXCD; wgid = (xcd < r ? xcd * (q + 1) : r * (q + 1) + (xcd - r) * q) + off; }
        const int nig = WGM * nN, gid = wgid / nig, fm = gid * WGM, gsz = (nM - fm) < WGM ? (nM - fm) : WGM;
        u.pm = fm + ((wgid % nig) % gsz); u.pn = (wgid % nig) / gsz; return true;
    }
    __device__ __forceinline__ void a_ready(const Unit&) const {}
    __device__ __forceinline__ void done(const Unit&) const {}
};
typedef __bf16 bf16v2_t __attribute__((ext_vector_type(2)));
typedef float f32v2_t __attribute__((ext_vector_type(2)));
__device__ __forceinline__ unsigned cvt_pk_bf16(float lo, float hi) { const f32v2_t v = {lo, hi}; const bf16v2_t b = __builtin_convertvector(v, bf16v2_t); return __builtin_bit_cast(unsigned, b); }
typedef float f32x2 __attribute__((ext_vector_type(2)));
typedef unsigned u32x2 __attribute__((ext_vector_type(2)));
__device__ __forceinline__ float fast_sigmoid(float x) { return __builtin_amdgcn_rcpf(1.0f + __builtin_amdgcn_exp2f(-1.4426950408889634f * x)); }
__device__ __forceinline__ float fast_silu(float x) { return x * fast_sigmoid(x); }
__device__ __forceinline__ float gelu_tanh(float x) { const float y = 1.5957691216057308f * (x + 0.044715f * x * x * x); return x * fast_sigmoid(y); }
__device__ __forceinline__ float bf_lo(unsigned w) { return __uint_as_float(w << 16); }
__device__ __forceinline__ float bf_hi(unsigned w) { return __uint_as_float(w & 0xffff0000u); }

__host__ __device__ __forceinline__ int frag_off(int row, int k, int NS) { return ((((row >> 4) * NS + (k >> 5)) * 64 + ((k >> 3) & 3) * 16 + (row & 15)) << 3) + (k & 7); }
__device__ __forceinline__ float log2_gamma(int h) { const float xg = __builtin_amdgcn_exp2f(-5.0f - (float)h); const float x2 = xg * xg; return -1.4426950408889634f * (xg + x2 * 0.5f + x2 * xg * (1.0f / 3.0f) + x2 * x2 * 0.25f + x2 * x2 * xg * 0.2f); }
struct EpiZ {
    static constexpr bool PERM = true, AFTER_DRAIN = false, HAS_MID = false;
    unsigned char* ws; float* stats; const float *cosT, *sinT;
    __device__ __forceinline__ void operator()(const f32x4 (&acc)[2][2][4][2], const Unit& u, int wr, int wc, int fr, int fq) const {
        const int pn = u.pn, row0 = u.pm * BM + wr * 64 + fr, cl = wc * 32 + 8 * fq;
        if (pn < 16) {
            const int h = pn & 7; const bool isk = pn >= 8;
            const float l2g = log2_gamma(h);
            bf16_t* dst = (bf16_t*)(ws + (isk ? WS_K : WS_Q));
#pragma unroll
            for (int ai = 0; ai < 2; ++ai)
#pragma unroll
                for (int m = 0; m < 4; ++m) {
                    const int r = row0 + ai * HALF + m * 16, nloc = r & 127;
                    const float sc = isk ? 0.0625f * __builtin_amdgcn_exp2f(-(float)nloc * l2g) : __builtin_amdgcn_exp2f((float)nloc * l2g);
                    const float* cp = cosT + (size_t)r * 128 + cl; const float* sp = sinT + (size_t)r * 128 + cl;
                    const f32x4 c0 = *(const f32x4*)cp, c1 = *(const f32x4*)(cp + 4), s0 = *(const f32x4*)sp, s1 = *(const f32x4*)(sp + 4);
                    const f32x4 xa = acc[ai][0][m][0], xb = acc[ai][0][m][1], ya = acc[ai][1][m][0], yb = acc[ai][1][m][1];
                    const f32x4 o1a = (xa * c0 - ya * s0) * sc, o1b = (xb * c1 - yb * s1) * sc, o2a = (ya * c0 + xa * s0) * sc, o2b = (yb * c1 + xb * s1) * sc;
                    u32x4 w1, w2; w1.x = cvt_pk_bf16(o1a[0], o1a[1]); w1.y = cvt_pk_bf16(o1a[2], o1a[3]); w1.z = cvt_pk_bf16(o1b[0], o1b[1]); w1.w = cvt_pk_bf16(o1b[2], o1b[3]);
                    w2.x = cvt_pk_bf16(o2a[0], o2a[1]); w2.y = cvt_pk_bf16(o2a[2], o2a[3]); w2.z = cvt_pk_bf16(o2b[0], o2b[1]); w2.w = cvt_pk_bf16(o2b[2], o2b[3]);
                    bf16_t* rowp = dst + (size_t)r * 2048 + 256 * h + cl;
                    *(u32x4*)rowp = w1; *(u32x4*)(rowp + 128) = w2;
                    if (isk) {
                        bf16_t* tb = (bf16_t*)(ws + WS_KT) + (size_t)(((r >> 12) * 8 + h) * 32 + ((r >> 7) & 31)) * 32768;
#pragma unroll
                        for (int q = 0; q < 4; ++q) { const unsigned a = w1[q], b = w2[q];
                            tb[frag_off(cl + 2 * q, r & 127, 4)] = (bf16_t)(a & 0xffffu); tb[frag_off(cl + 2 * q + 1, r & 127, 4)] = (bf16_t)(a >> 16);
                            tb[frag_off(128 + cl + 2 * q, r & 127, 4)] = (bf16_t)(b & 0xffffu); tb[frag_off(128 + cl + 2 * q + 1, r & 127, 4)] = (bf16_t)(b >> 16); }
                    }
                    asm volatile("" ::: "memory");
                }
        } else if (pn < 24 || (pn >= 40 && pn < 48)) {
            const bool iss = pn >= 40; bf16_t* T = (bf16_t*)(ws + (iss ? WS_ST : WS_VT)); const int ct = (iss ? pn - 40 : pn - 16) * 256;
#pragma unroll
            for (int ai = 0; ai < 2; ++ai)
#pragma unroll
                for (int m = 0; m < 4; ++m) {
                    const int r = row0 + ai * HALF + m * 16; float sum = 0.f, sq = 0.f;
#pragma unroll
                    for (int bj = 0; bj < 2; ++bj)
#pragma unroll
                        for (int n = 0; n < 2; ++n) {
                            f32x4 v = acc[ai][bj][m][n];
                            if (iss) { v[0] = gelu_tanh(v[0]); v[1] = gelu_tanh(v[1]); v[2] = gelu_tanh(v[2]); v[3] = gelu_tanh(v[3]); }
                            const unsigned a = cvt_pk_bf16(v[0], v[1]), b = cvt_pk_bf16(v[2], v[3]);
                            if (iss) { const float f0 = bf_lo(a), f1 = bf_hi(a), f2 = bf_lo(b), f3 = bf_hi(b); sum += (f0 + f1) + (f2 + f3); sq += (f0 * f0 + f1 * f1) + (f2 * f2 + f3 * f3); }
                            const int cc = ct + bj * HALF + cl + 4 * n, rr = iss ? cc : (cc & 255);
                            bf16_t* t = T + (iss ? (size_t)(r >> 7) * 262144 : (size_t)(((r >> 12) * 8 + (ct >> 8)) * 32 + ((r >> 7) & 31)) * 32768);
                            t[frag_off(rr, r & 127, 4)] = (bf16_t)(a & 0xffffu); t[frag_off(rr + 1, r & 127, 4)] = (bf16_t)(a >> 16); t[frag_off(rr + 2, r & 127, 4)] = (bf16_t)(b & 0xffffu); t[frag_off(rr + 3, r & 127, 4)] = (bf16_t)(b >> 16);
                        }
                    if (iss) {
                        sum += __shfl_xor(sum, 16); sum += __shfl_xor(sum, 32); sq += __shfl_xor(sq, 16); sq += __shfl_xor(sq, 32);
                        if (fq == 0) { f32x2 o; o.x = sum; o.y = sq; *(f32x2*)(stats + (size_t)r * 64 + ((pn - 40) * 4 + wc) * 2) = o; }
                    }
                    asm volatile("" ::: "memory");
                }
        } else {
            const int kind = pn < 32 ? 0 : (pn < 40 ? 1 : 2);
            size_t doff; int ldc, ct;
            if (pn < 32) { doff = WS_GS; ldc = 2048; ct = (pn - 24) * 256; } else if (pn < 40) { doff = WS_UG; ldc = 2048; ct = (pn - 32) * 256; }
            else if (pn < 64) { doff = WS_SIGR; ldc = 4096; ct = (pn - 48) * 256; } else { doff = WS_SIGS; ldc = 4096; ct = (pn - 64) * 256; }
            bf16_t* dst = (bf16_t*)(ws + doff);
#pragma unroll
            for (int ai = 0; ai < 2; ++ai)
#pragma unroll
                for (int m = 0; m < 4; ++m) {
                    const int r = row0 + ai * HALF + m * 16; bf16_t* rowp = dst + (size_t)r * ldc + ct + cl;
#pragma unroll
                    for (int bj = 0; bj < 2; ++bj) {
                        f32x4 v0 = acc[ai][bj][m][0], v1 = acc[ai][bj][m][1];
#pragma unroll
                        for (int j = 0; j < 4; ++j) {
                            if (kind == 0) { v0[j] = fast_silu(v0[j]); v1[j] = fast_silu(v1[j]); }
                            else if (kind == 1) { v0[j] = gelu_tanh(v0[j]); v1[j] = gelu_tanh(v1[j]); }
                            else { v0[j] = fast_sigmoid(v0[j]); v1[j] = fast_sigmoid(v1[j]); } }
                        u32x4 w; w.x = cvt_pk_bf16(v0[0], v0[1]); w.y = cvt_pk_bf16(v0[2], v0[3]); w.z = cvt_pk_bf16(v1[0], v1[1]); w.w = cvt_pk_bf16(v1[2], v1[3]);
                        *(u32x4*)(rowp + bj * HALF) = w; }
                }
        }
    }
};

struct EpiSwiGLU {
    static constexpr bool PERM = true, AFTER_DRAIN = false, HAS_MID = false;
    bf16_t* O; int ldc;
    __device__ __forceinline__ void operator()(const f32x4 (&acc)[2][2][4][2], const Unit& u, int wr, int wc, int fr, int fq) const {
        const int row0 = u.pm * BM + wr * 64 + fr, col0 = u.pn * HALF + wc * 32 + 8 * fq;
#pragma unroll
        for (int ai = 0; ai < 2; ++ai)
#pragma unroll
            for (int m = 0; m < 4; ++m) {
                const f32x4 g0 = acc[ai][0][m][0], g1 = acc[ai][0][m][1], u0 = acc[ai][1][m][0], u1 = acc[ai][1][m][1]; f32x4 v0, v1;
#pragma unroll
                for (int j = 0; j < 4; ++j) { v0[j] = fast_silu(g0[j]) * u0[j]; v1[j] = fast_silu(g1[j]) * u1[j]; }
                u32x4 w; w.x = cvt_pk_bf16(v0[0], v0[1]); w.y = cvt_pk_bf16(v0[2], v0[3]); w.z = cvt_pk_bf16(v1[0], v1[1]); w.w = cvt_pk_bf16(v1[2], v1[3]);
                *(u32x4*)(O + (size_t)(row0 + ai * HALF + m * 16) * ldc + col0) = w; }
    }
};

template <int MODE> struct EpiMix {
    static constexpr bool PERM = false, AFTER_DRAIN = false, HAS_MID = false;
    const bf16_t* gate; float* T; bf16_t* O; int ldc;
    __device__ __forceinline__ void operator()(const f32x4 (&acc)[2][2][4][2], const Unit& u, int wr, int wc, int fr, int fq) const {
        const int row0 = u.pm * BM + wr * 64 + fr, col0 = u.pn * BM + wc * 32 + 4 * fq;
#pragma unroll
        for (int ai = 0; ai < 2; ++ai)
#pragma unroll
            for (int m = 0; m < 4; ++m) { const size_t off = (size_t)(row0 + ai * HALF + m * 16) * ldc + col0;
#pragma unroll
                for (int bj = 0; bj < 2; ++bj)
#pragma unroll
                    for (int n = 0; n < 2; ++n) { const size_t o = off + bj * HALF + n * 16;
                        const u32x2 gw = *(const u32x2*)(gate + o); const f32x4 gv = (f32x4){bf_lo(gw.x), bf_hi(gw.x), bf_lo(gw.y), bf_hi(gw.y)};
                        if (MODE == 0) { *(f32x4*)(T + o) = gv * acc[ai][bj][m][n]; }
                        else { const f32x4 v = *(const f32x4*)(T + o) + gv * acc[ai][bj][m][n]; u32x2 w; w.x = cvt_pk_bf16(v[0], v[1]); w.y = cvt_pk_bf16(v[2], v[3]); *(u32x2*)(O + o) = w; } } }
    }
};

template <bool RES_BF16> struct EpiRes {
    static constexpr bool PERM = true, AFTER_DRAIN = false, HAS_MID = false;
    const void* res; bf16_t* P; int ldc; const float* ga; const float* gb; int ga_stride; int rows_per_batch; float alpha;
    __device__ __forceinline__ void operator()(const f32x4 (&acc)[2][2][4][2], const Unit& u, int wr, int wc, int fr, int fq) const {
        const int row0 = u.pm * BM + wr * 64 + fr, col0 = u.pn * BM + wc * 32 + 8 * fq; const int b = (u.pm * BM) / rows_per_batch;
        f32x4 gv[2][2];
#pragma unroll
        for (int bj = 0; bj < 2; ++bj)
#pragma unroll
            for (int n = 0; n < 2; ++n) gv[bj][n] = *(const f32x4*)(ga + (size_t)b * ga_stride + col0 + bj * HALF + n * 4) + *(const f32x4*)(gb + col0 + bj * HALF + n * 4) + 1.0f;
#pragma unroll
        for (int ai = 0; ai < 2; ++ai)
#pragma unroll
            for (int m = 0; m < 4; ++m) { const size_t off = (size_t)(row0 + ai * HALF + m * 16) * ldc + col0;
#pragma unroll
                for (int bj = 0; bj < 2; ++bj) { const size_t o = off + bj * HALF;
                    f32x4 r0, r1;
                    if (RES_BF16) { const u32x4 rw = *(const u32x4*)((const bf16_t*)res + o); r0 = (f32x4){bf_lo(rw.x), bf_hi(rw.x), bf_lo(rw.y), bf_hi(rw.y)}; r1 = (f32x4){bf_lo(rw.z), bf_hi(rw.z), bf_lo(rw.w), bf_hi(rw.w)}; }
                    else { r0 = *(const f32x4*)((const float*)res + o); r1 = *(const f32x4*)((const float*)res + o + 4); }
                    const f32x4 v0 = r0 * alpha + gv[bj][0] * acc[ai][bj][m][0], v1 = r1 * alpha + gv[bj][1] * acc[ai][bj][m][1];
                    u32x4 w; w.x = cvt_pk_bf16(v0[0], v0[1]); w.y = cvt_pk_bf16(v0[2], v0[3]); w.z = cvt_pk_bf16(v1[0], v1[1]); w.w = cvt_pk_bf16(v1[2], v1[3]);
                    *(u32x4*)(P + o) = w; } }
    }
};

struct EpiMixCat {
    static constexpr bool PERM = true, AFTER_DRAIN = false, HAS_MID = true;
    const bf16_t* SR; const bf16_t* SS; bf16_t* O; int ldc;
    __device__ __forceinline__ void mid(f32x4 (&acc)[2][2][4][2], const Unit& u, int wr, int wc, int fr, int fq) const {
        unsigned boff = (unsigned)((u.pm * BM + wr * 64 + fr) * ldc + u.pn * BM + wc * 32 + 8 * fq) * 2u; asm volatile("" : "+v"(boff));
        const __attribute__((address_space(1))) char* sr = (const __attribute__((address_space(1))) char*)SR; const __attribute__((address_space(1))) char* ss = (const __attribute__((address_space(1))) char*)SS;
#pragma unroll
        for (int ai = 0; ai < 2; ++ai)
#pragma unroll
            for (int m = 0; m < 4; ++m) {
#pragma unroll
                for (int bj = 0; bj < 2; ++bj) { const unsigned o = boff + (unsigned)((ai * HALF + m * 16) * ldc + bj * HALF) * 2u;
                    const u32x4 a = *(const __attribute__((address_space(1))) u32x4*)(sr + o), b = *(const __attribute__((address_space(1))) u32x4*)(ss + o);
#pragma unroll
                    for (int q = 0; q < 4; ++q) { const float r0 = bf_lo(a[q]) * __builtin_amdgcn_rcpf(fmaxf(bf_lo(b[q]), 1e-20f)), r1 = bf_hi(a[q]) * __builtin_amdgcn_rcpf(fmaxf(bf_hi(b[q]), 1e-20f));
                        acc[ai][bj][m][q >> 1][(q & 1) * 2] *= r0; acc[ai][bj][m][q >> 1][(q & 1) * 2 + 1] *= r1; } }
                asm volatile("" ::: "memory"); }
    }
    __device__ __forceinline__ void operator()(const f32x4 (&acc)[2][2][4][2], const Unit& u, int wr, int wc, int fr, int fq) const {
        const int row0 = u.pm * BM + wr * 64 + fr, col0 = u.pn * BM + wc * 32 + 8 * fq;
#pragma unroll
        for (int ai = 0; ai < 2; ++ai)
#pragma unroll
            for (int m = 0; m < 4; ++m) { const size_t off = (size_t)(row0 + ai * HALF + m * 16) * ldc + col0;
#pragma unroll
                for (int bj = 0; bj < 2; ++bj) { const u32x4 b = *(const u32x4*)(SS + off + bj * HALF); u32x4 w;
#pragma unroll
                    for (int q = 0; q < 4; ++q) { const float s0 = fmaxf(bf_lo(b[q]), 1e-20f), s1 = fmaxf(bf_hi(b[q]), 1e-20f);
                        w[q] = cvt_pk_bf16(acc[ai][bj][m][q >> 1][(q & 1) * 2] * s0, acc[ai][bj][m][q >> 1][(q & 1) * 2 + 1] * s1); }
                    *(u32x4*)(O + off + bj * HALF) = w; } }
    }
};

struct EpiNull {
    static constexpr bool PERM = true, AFTER_DRAIN = false, HAS_MID = false;
    float* sink;
    __device__ __forceinline__ void operator()(const f32x4 (&acc)[2][2][4][2], const Unit& u, int wr, int wc, int fr, int fq) const {
        float s = 0.f;
#pragma unroll
        for (int ai = 0; ai < 2; ++ai)
#pragma unroll
            for (int bj = 0; bj < 2; ++bj)
#pragma unroll
                for (int m = 0; m < 4; ++m)
#pragma unroll
                    for (int n = 0; n < 2; ++n) s += (acc[ai][bj][m][n][0] + acc[ai][bj][m][n][1]) + (acc[ai][bj][m][n][2] + acc[ai][bj][m][n][3]);
        if (s == 123456.789f) sink[0] = s;
    }
};
template <class Epi, class Sched, bool ALIGN_EPI = false, bool SP2 = false>
__device__ __forceinline__ void gemm_phase(PG8_LAS unsigned char* lds, const Gemm g, const Sched& S, const Epi& E) {
    int tid = threadIdx.x; asm volatile("" : "+v"(tid));
    const int wid = __builtin_amdgcn_readfirstlane(tid >> 6), lane = tid & 63, wr = wid >> 2, wc = wid & 3, fr = lane & 15, fq = lane >> 4;
    const int K = g.K, nt = K / BK;
    unsigned voffA[2], voffB[2];
#pragma unroll
    for (int i = 0; i < 2; ++i) { int R, C; stage_rc(tid * 16 + i * 8192, R, C); const int Rb = Epi::PERM ? ((R & ~31) + perm32(R & 31)) : R;
        voffA[i] = (unsigned)(R * K + C) * 2u; voffB[i] = (unsigned)(Rb * K + C) * 2u; }
    const size_t kstep = (size_t)(BK * 2);
    const size_t hstep = (size_t)HALF * K * 2;
    const size_t tstep = 2 * hstep;
    const unsigned ldsw = (unsigned)wid * 1024u;
    const int aoff = lds_byte(wr * 64 + fr, fq * 8), boff = lds_byte(wc * 32 + fr, fq * 8);
#define PG8_SA(b, h) (((b) * 2 + (h)) * HTB)
#define PG8_SB(b, h) ((4 + (b) * 2 + (h)) * HTB)
#define PG8_STAGE(bufoff, gbase, voff) do { _Pragma("unroll") for (int _i = 0; _i < 2; ++_i) \
        __builtin_amdgcn_global_load_lds((const unsigned*)((const char*)(gbase) + (voff)[_i]), (PG8_LAS unsigned*)(lds + (bufoff) + ldsw + _i * 8192), 16, 0, 0); } while (0)
#define PG8_LDA(dst, b, h) do { _Pragma("unroll") for (int m = 0; m < 4; ++m) _Pragma("unroll") for (int k = 0; k < 2; ++k) dst[m][k] = *(const PG8_LAS bf16x8*)(lds + PG8_SA(b, h) + aoff + m * 2048 + k * 1024); } while (0)
#define PG8_LDB(dst, b, h) do { _Pragma("unroll") for (int n = 0; n < 2; ++n) _Pragma("unroll") for (int k = 0; k < 2; ++k) dst[n][k] = *(const PG8_LAS bf16x8*)(lds + PG8_SB(b, h) + boff + n * 2048 + k * 1024); } while (0)
#define PG8_MMA(ai, bj, At, Bt) do { __builtin_amdgcn_s_setprio(1); _Pragma("unroll") for (int m = 0; m < 4; ++m) _Pragma("unroll") for (int n = 0; n < 2; ++n) _Pragma("unroll") for (int k = 0; k < 2; ++k) \
        acc[ai][bj][m][n] = __builtin_amdgcn_mfma_f32_16x16x32_bf16(Bt[n][k], At[m][k], acc[ai][bj][m][n], 0, 0, 0); __builtin_amdgcn_s_setprio(0); } while (0)
#define PG8_WAIT_V(n) asm volatile("s_waitcnt vmcnt(" #n ")" ::: "memory")
#define PG8_WAIT_L(n) asm volatile("s_waitcnt lgkmcnt(" #n ")" ::: "memory")
#define PG8_BAR __builtin_amdgcn_s_barrier()
#define PG8_SCHED __builtin_amdgcn_sched_barrier(0)
    Unit cur, nxt; int ui = 0;
    if (!S.next(0, cur)) return;
    f32x4 acc[2][2][4][2];
#pragma unroll
    for (int a = 0; a < 2; ++a)
#pragma unroll
        for (int b = 0; b < 2; ++b)
#pragma unroll
            for (int m = 0; m < 4; ++m)
#pragma unroll
                for (int n = 0; n < 2; ++n) acc[a][b][m][n] = (f32x4){0.f, 0.f, 0.f, 0.f};
    bf16x8 At[4][2], B0[2][2], B1[2][2];
    const char* cA = (const char*)g.A + (size_t)cur.pm * tstep; const char* cB = (const char*)g.Bt + (size_t)cur.pn * tstep;
    S.a_ready(cur);
    if constexpr (SP2) {
        PG8_STAGE(PG8_SB(0, 0), cB, voffB); PG8_STAGE(PG8_SB(0, 1), cB + hstep, voffB); PG8_STAGE(PG8_SA(0, 0), cA, voffA); PG8_STAGE(PG8_SA(0, 1), cA + hstep, voffA);
        if (wr == 1) PG8_BAR;
        PG8_WAIT_V(2); PG8_BAR;
        PG8_STAGE(PG8_SB(1, 0), cB + kstep, voffB); PG8_STAGE(PG8_SA(1, 0), cA + kstep, voffA); PG8_STAGE(PG8_SB(1, 1), cB + hstep + kstep, voffB);
        PG8_WAIT_V(6); PG8_BAR;
    } else {
        PG8_STAGE(PG8_SB(0, 0), cB, voffB); PG8_STAGE(PG8_SA(0, 0), cA, voffA); PG8_STAGE(PG8_SB(0, 1), cB + hstep, voffB); PG8_STAGE(PG8_SA(0, 1), cA + hstep, voffA);
        if (wr == 1) PG8_BAR;
        PG8_WAIT_V(4); PG8_BAR;
        PG8_STAGE(PG8_SB(1, 0), cB + kstep, voffB); PG8_STAGE(PG8_SA(1, 0), cA + kstep, voffA); PG8_STAGE(PG8_SB(1, 1), cB + hstep + kstep, voffB);
        PG8_WAIT_V(6); PG8_BAR;
    }
#ifdef GP_STAMP
    unsigned long long gp_tk = 0, gp_te = 0, gp_tf = 0, gp_ts = __builtin_amdgcn_s_memrealtime(), gp_tm = 0;
#endif
    for (;;) {
        const bool has_next = S.next(ui + 1, nxt);
        const char* nA = has_next ? (const char*)g.A + (size_t)nxt.pm * tstep : cA; const char* nB = has_next ? (const char*)g.Bt + (size_t)nxt.pn * tstep : cB;
        for (int t = 0; t < nt; t += 2) {
            if constexpr (Epi::HAS_MID) { if (t == (nt >> 1)) E.mid(acc, cur, wr, wc, fr, fq); }
#ifdef GP_STAMP
            if (t == 4) gp_tf += __builtin_amdgcn_s_memrealtime() - gp_ts;
#endif
            const bool last = (t == nt - 2);
            const char* a1 = cA + (size_t)(t + 1) * kstep;
            const char* a2 = last ? nA : cA + (size_t)(t + 2) * kstep; const char* b2 = last ? nB : cB + (size_t)(t + 2) * kstep;
            const char* a3 = a2 + kstep; const char* b3 = b2 + kstep;
            if (last && has_next) S.a_ready(nxt);
            if constexpr (SP2) {
            PG8_LDB(B0, 0, 0); PG8_LDB(B1, 0, 1); PG8_SCHED; PG8_LDA(At, 0, 0); PG8_STAGE(PG8_SA(1, 1), a1 + hstep, voffA);
            PG8_WAIT_V(8); PG8_WAIT_L(0); PG8_BAR; PG8_MMA(0, 0, At, B0); PG8_MMA(0, 1, At, B1); PG8_BAR; PG8_SCHED;
            PG8_LDA(At, 0, 1); PG8_STAGE(PG8_SB(0, 0), b2, voffB); PG8_STAGE(PG8_SB(0, 1), b2 + hstep, voffB); PG8_STAGE(PG8_SA(0, 0), a2, voffA);
            PG8_WAIT_V(8); PG8_WAIT_L(0); PG8_BAR; PG8_MMA(1, 0, At, B0); PG8_MMA(1, 1, At, B1); PG8_BAR; PG8_SCHED;
            PG8_LDB(B0, 1, 0); PG8_LDB(B1, 1, 1); PG8_SCHED; PG8_LDA(At, 1, 0); PG8_STAGE(PG8_SA(0, 1), a2 + hstep, voffA);
            PG8_WAIT_V(8); PG8_WAIT_L(0); PG8_BAR; PG8_MMA(0, 0, At, B0); PG8_MMA(0, 1, At, B1); PG8_BAR; PG8_SCHED;
            PG8_LDA(At, 1, 1); PG8_STAGE(PG8_SB(1, 0), b3, voffB); PG8_STAGE(PG8_SB(1, 1), b3 + hstep, voffB); PG8_STAGE(PG8_SA(1, 0), a3, voffA);
            PG8_WAIT_V(8); PG8_WAIT_L(0); PG8_BAR; PG8_MMA(1, 0, At, B0); PG8_MMA(1, 1, At, B1); PG8_BAR; PG8_SCHED;
            } else {
            PG8_LDB(B0, 0, 0); PG8_SCHED; PG8_LDA(At, 0, 0); PG8_STAGE(PG8_SA(1, 1), a1 + hstep, voffA);
            PG8_WAIT_L(8); PG8_BAR; PG8_WAIT_L(0); PG8_MMA(0, 0, At, B0); PG8_BAR; PG8_SCHED;
            PG8_LDB(B1, 0, 1); PG8_STAGE(PG8_SB(0, 0), b2, voffB);
            PG8_BAR; PG8_WAIT_L(0); PG8_MMA(0, 1, At, B1); PG8_BAR;
            PG8_LDA(At, 0, 1); PG8_STAGE(PG8_SA(0, 0), a2, voffA);
            PG8_BAR; PG8_WAIT_L(0); PG8_MMA(1, 0, At, B0); PG8_BAR; PG8_SCHED;
            PG8_STAGE(PG8_SB(0, 1), b2 + hstep, voffB);
            PG8_WAIT_V(6); PG8_BAR; PG8_MMA(1, 1, At, B1); PG8_BAR;
            PG8_LDB(B0, 1, 0); PG8_SCHED; PG8_LDA(At, 1, 0); PG8_STAGE(PG8_SA(0, 1), a2 + hstep, voffA);
            PG8_WAIT_L(8); PG8_BAR; PG8_WAIT_L(0); PG8_MMA(0, 0, At, B0); PG8_BAR; PG8_SCHED;
            PG8_LDB(B1, 1, 1); PG8_STAGE(PG8_SB(1, 0), b3, voffB);
            PG8_BAR; PG8_WAIT_L(0); PG8_MMA(0, 1, At, B1); PG8_BAR;
            PG8_LDA(At, 1, 1); PG8_STAGE(PG8_SA(1, 0), a3, voffA);
            PG8_BAR; PG8_WAIT_L(0); PG8_MMA(1, 0, At, B0); PG8_BAR; PG8_SCHED;
            PG8_STAGE(PG8_SB(1, 1), b3 + hstep, voffB);
            PG8_WAIT_V(6); PG8_BAR; PG8_MMA(1, 1, At, B1); PG8_BAR;
            }
        }
#ifdef GP_STAMP
        gp_tm = __builtin_amdgcn_s_memrealtime(); gp_tk += gp_tm - gp_ts;
#endif
        if constexpr (ALIGN_EPI) { if (wr == 0) PG8_BAR; }
        if constexpr (!Epi::AFTER_DRAIN) { E(acc, cur, wr, wc, fr, fq); S.done(cur); }
        if (!has_next) break;
#pragma unroll
        for (int a = 0; a < 2; ++a)
#pragma unroll
            for (int b = 0; b < 2; ++b)
#pragma unroll
                for (int m = 0; m < 4; ++m)
#pragma unroll
                    for (int n = 0; n < 2; ++n) acc[a][b][m][n] = (f32x4){0.f, 0.f, 0.f, 0.f};
        cur = nxt; cA = nA; cB = nB; ++ui;
        if constexpr (ALIGN_EPI) { if (wr == 1) PG8_BAR; }
#ifdef GP_STAMP
        gp_ts = __builtin_amdgcn_s_memrealtime(); gp_te += gp_ts - gp_tm;
#endif
    }
#ifdef GP_STAMP
    if (S.prb && blockIdx.x == 0 && threadIdx.x == 0) { S.prb[0] += gp_tk; S.prb[1] += gp_te + (__builtin_amdgcn_s_memrealtime() - gp_tm); S.prb[2] += gp_tf; }
#endif
    PG8_WAIT_V(0);
    if constexpr (!ALIGN_EPI) { if (wr == 0) PG8_BAR; }
    PG8_BAR;
    if constexpr (Epi::AFTER_DRAIN) { E.fused(acc, cur, wr, wc, fr, fq, lds, wid, lane); S.done(cur); }
#undef PG8_SA
#undef PG8_SB
#undef PG8_STAGE
#undef PG8_LDA
#undef PG8_LDB
#undef PG8_MMA
#undef PG8_WAIT_V
#undef PG8_WAIT_L
#undef PG8_BAR
#undef PG8_SCHED
}
}
#define GAS __attribute__((address_space(1)))
#define LAS __attribute__((address_space(3)))
typedef unsigned short bf16;
typedef unsigned v4u __attribute__((ext_vector_type(4)));
typedef float f32x4 __attribute__((ext_vector_type(4)));
typedef short bf16x8 __attribute__((ext_vector_type(8)));
typedef GAS unsigned gu32;
typedef GAS unsigned long long gu64;
#define RLX_AGENT __ATOMIC_RELAXED, __HIP_MEMORY_SCOPE_AGENT
#define LDS_WAIT() asm volatile("s_waitcnt lgkmcnt(0)" ::: "memory")
#define VM_WAIT() asm volatile("s_waitcnt vmcnt(0)" ::: "memory")
__device__ __forceinline__ unsigned long long rt() { return __builtin_amdgcn_s_memrealtime(); }
__device__ __forceinline__ unsigned f2bf(float f) { unsigned u = __builtin_bit_cast(unsigned, f); return (u + 0x7fffu + ((u >> 16) & 1u)) >> 16; }
__device__ __forceinline__ unsigned pk2(float lo, float hi) { return f2bf(lo) | (f2bf(hi) << 16); }
#define XB_TMO      128
#define XB_XCNT(j)  (256  + 64 * (j))
#define XB_XSUB(j)  (1280 + 64 * (j))
#define XB_XGEN(j)  (2304 + 64 * (j))
#define XB_TOP      3328
#define XB_TOPGEN   3392
#define XCD_BAR_WORDS 3456
#define XB_SPIN_CAP (1u << 18)

__device__ __forceinline__ unsigned xb_ld(unsigned* p)              { return __hip_atomic_load(p, __ATOMIC_RELAXED, __HIP_MEMORY_SCOPE_AGENT); }
__device__ __forceinline__ unsigned xb_add(unsigned* p, unsigned v) { return __hip_atomic_fetch_add(p, v, __ATOMIC_RELAXED, __HIP_MEMORY_SCOPE_AGENT); }
__device__ __forceinline__ unsigned xb_xcc_id() { return (unsigned)__builtin_amdgcn_s_getreg((3 << 11) | 20) & 0xFu; }
#define XB_SPIN(cond, bar) do { unsigned _sp = 0; while (cond) { __builtin_amdgcn_s_sleep(1); \
    if ((++_sp & 255u) == 0u) { if (xb_ld(&(bar)[XB_TMO])) break; if (_sp > XB_SPIN_CAP) { atomicAdd(&(bar)[XB_TMO], 1u); break; } } } } while (0)

struct XcdBarrier {
    unsigned* bar; unsigned x;
    volatile LAS unsigned* st;
};

__device__ __forceinline__ XcdBarrier xcd_barrier_post(unsigned* bar, volatile LAS unsigned* st) {
    XcdBarrier b; b.bar = bar; b.x = xb_xcc_id(); b.st = st;
    if (threadIdx.x == 0) (void)xb_add(&bar[XB_XCNT(b.x)], 1u);
    return b;
}
__device__ __forceinline__ void xcd_barrier_complete(unsigned* bar, unsigned x, unsigned& nloc, unsigned& nx) {
    const unsigned G = gridDim.x * gridDim.y * gridDim.z;
    unsigned sum, cnt, mine, sp = 0u;
    for (;;) {
        sum = 0u; cnt = 0u; mine = 0u;
#pragma unroll
        for (unsigned j = 0; j < 16; ++j) { const unsigned c = xb_ld(&bar[XB_XCNT(j)]); sum += c; cnt += (c > 0u) ? 1u : 0u; mine = (j == x) ? c : mine; }
        if (sum == G) break;
        __builtin_amdgcn_s_sleep(1);
        if ((++sp & 255u) == 0u) { if (xb_ld(&bar[XB_TMO])) break; if (sp > XB_SPIN_CAP) { atomicAdd(&bar[XB_TMO], 1u); break; } }
    }
    nloc = mine > 0u ? mine : 1u; nx = cnt > 0u ? cnt : 1u;
}

__device__ __forceinline__ void xcd_barrier(const XcdBarrier& b) {
    asm volatile("s_waitcnt vmcnt(0)" ::: "memory");
    __syncthreads();
    if (threadIdx.x == 0) {
        unsigned* bar = b.bar;
        __builtin_amdgcn_s_waitcnt(0);
        unsigned nloc = b.st[0], nx = b.st[1];
        if (nloc == 0u) { xcd_barrier_complete(bar, b.x, nloc, nx); b.st[0] = nloc; b.st[1] = nx; }
        const unsigned old = xb_add(&bar[XB_XSUB(b.x)], 1u);
        const unsigned gen = old / nloc;
        if (old + 1u == (gen + 1u) * nloc) {
            __builtin_amdgcn_fence(__ATOMIC_RELEASE, "agent");
            asm volatile("s_waitcnt vmcnt(0)" ::: "memory");
            const unsigned og = xb_add(&bar[XB_TOP], 1u);
            const unsigned tg = og / nx;
            if (og + 1u == (tg + 1u) * nx) xb_add(&bar[XB_TOPGEN], 1u);
            else XB_SPIN(xb_ld(&bar[XB_TOPGEN]) == tg, bar);
            __builtin_amdgcn_fence(__ATOMIC_ACQUIRE, "agent");
            xb_add(&bar[XB_XGEN(b.x)], 1u);
            asm volatile("s_waitcnt vmcnt(0)" ::: "memory");
        } else {
            XB_SPIN(xb_ld(&bar[XB_XGEN(b.x)]) == gen, bar);
            __builtin_amdgcn_fence(__ATOMIC_ACQUIRE, "agent");
            asm volatile("s_waitcnt vmcnt(0)" ::: "memory");
        }
    }
    __syncthreads();
}

typedef unsigned u32x2 __attribute__((ext_vector_type(2)));
typedef float f32x2 __attribute__((ext_vector_type(2)));
#define MFMA16(a, b, c) __builtin_amdgcn_mfma_f32_16x16x32_bf16((a), (b), (c), 0, 0, 0)
__device__ __forceinline__ float wave_sum(float v) {
#pragma unroll
    for (int o = 1; o < 64; o <<= 1) v += __shfl_xor(v, o);
    return v;
}
__device__ __forceinline__ float bflo(unsigned w) { return __uint_as_float(w << 16); }
__device__ __forceinline__ float bfhi(unsigned w) { return __uint_as_float(w & 0xffff0000u); }
__device__ __forceinline__ unsigned pkbf(float lo, float hi) { return pg8::cvt_pk_bf16(lo, hi); }

#ifndef GP_ALIGN
#define GP_ALIGN true
#endif
#ifndef GP_SP2
#define GP_SP2 true
#endif
struct Args { const float* in[19]; float* out; unsigned char* ws; int ph_lo, ph_hi; };

__device__ __forceinline__ void p0_transpose_item(const float* W, int K, int N, bf16* WT, int kb, int n0, int row0, int lane, LAS unsigned char* scr, int ldt = 0, int koff = 0) {
    const GAS float* src = (const GAS float*)W + (size_t)(kb * 64) * N + n0 + lane;
    float v[64];
#pragma unroll
    for (int i = 0; i < 64; ++i) v[i] = __builtin_nontemporal_load(src + (size_t)i * N);
#pragma unroll
    for (int c = 0; c < 8; ++c) { v4u o; o.x = pkbf(v[8 * c], v[8 * c + 1]); o.y = pkbf(v[8 * c + 2], v[8 * c + 3]); o.z = pkbf(v[8 * c + 4], v[8 * c + 5]); o.w = pkbf(v[8 * c + 6], v[8 * c + 7]);
        *(LAS v4u*)(scr + lane * 144 + c * 16) = o; }
    const int rl = lane >> 3, cl = lane & 7;
    GAS bf16* dst = (GAS bf16*)WT + (size_t)(row0 + rl) * (ldt ? ldt : K) + koff + kb * 64 + cl * 8;
    const size_t rstep = (size_t)8 * (ldt ? ldt : K);
#pragma unroll
    for (int j = 0; j < 8; ++j) { const v4u o = *(const LAS v4u*)(scr + (8 * j + rl) * 144 + cl * 16); *(GAS v4u*)(dst + j * rstep) = o; }
}
__device__ __forceinline__ int gu_row0(int n0) {
    const int up = n0 >= DFF ? 1 : 0, j = n0 - up * DFF; return 256 * (j >> 7) + 128 * up + (j & 127);
}

template <int MODE> __device__ __forceinline__ void row_pass(int gw, int NGW, int lane, const void* src, const float* lg, const float* lb, float* Yf, bf16* Yb, bf16* H,
                                                             const float* ada, const float* bada, int seg_sh, int seg_sc) {
#define RP_F4(base, boff) (*(const GAS f32x4*)((const GAS char*)(base) + (boff)))
#define RP_U4(base, boff) (*(const GAS v4u*)((const GAS char*)(base) + (boff)))
    for (int row = gw; row < M; row += NGW) {
        const int b = row / SEQ;
        unsigned l16; asm volatile("v_lshlrev_b32 %0, 4, %1" : "=v"(l16) : "v"(lane));
        const unsigned l32 = 2u * l16;
        f32x4 v[8][2];
        if (MODE == 0) {
            const float* sp = (const float*)src + (size_t)row * D;
#pragma unroll
            for (int j = 0; j < 8; ++j) { v[j][0] = RP_F4(sp, 2048u * j + l32); v[j][1] = RP_F4(sp, 2048u * j + 16u + l32); }
        } else {
            const bf16* sp = (const bf16*)src + (size_t)row * D;
#pragma unroll
            for (int j = 0; j < 8; ++j) { const v4u w = RP_U4(sp, 1024u * j + l16); v[j][0] = (f32x4){bflo(w.x), bfhi(w.x), bflo(w.y), bfhi(w.y)}; v[j][1] = (f32x4){bflo(w.z), bfhi(w.z), bflo(w.w), bfhi(w.w)}; }
            float s = 0.f;
#pragma unroll
            for (int j = 0; j < 8; ++j) s += ((v[j][0].x + v[j][0].y) + (v[j][0].z + v[j][0].w)) + ((v[j][1].x + v[j][1].y) + (v[j][1].z + v[j][1].w));
            const float mean = wave_sum(s) * (1.f / D); float s2 = 0.f;
#pragma unroll
            for (int j = 0; j < 8; ++j)
#pragma unroll
                for (int q = 0; q < 2; ++q) { v[j][q] = v[j][q] - mean; s2 += (v[j][q].x * v[j][q].x + v[j][q].y * v[j][q].y) + (v[j][q].z * v[j][q].z + v[j][q].w * v[j][q].w); }
            const float rstd = 1.0f / sqrtf(wave_sum(s2) * (1.f / D) + LN_EPS);
            const float* ash = ada + (size_t)b * ADAW + seg_sh * D; const float* bsh = bada + seg_sh * D;
            const float* asc = ada + (size_t)b * ADAW + seg_sc * D; const float* bsc = bada + seg_sc * D;
            float* ypf = Yf + (size_t)row * D; bf16* ypb = Yb + (size_t)row * D; bf16* hp = H + (size_t)row * D;
#pragma unroll
            for (int j = 0; j < 8; ++j) {
                f32x4 y[2];
#pragma unroll
                for (int q = 0; q < 2; ++q) { const unsigned bo = 2048u * j + 16u * q + l32; y[q] = v[j][q] * rstd * RP_F4(lg, bo) + RP_F4(lb, bo); }
                if (MODE == 2) { *(GAS f32x4*)((GAS char*)ypf + (2048u * j + l32)) = y[0]; *(GAS f32x4*)((GAS char*)ypf + (2048u * j + 16u + l32)) = y[1]; }
                else {
                    v4u w; w.x = pkbf(y[0].x, y[0].y); w.y = pkbf(y[0].z, y[0].w); w.z = pkbf(y[1].x, y[1].y); w.w = pkbf(y[1].z, y[1].w); *(GAS v4u*)((GAS char*)ypb + (1024u * j + l16)) = w;
                    f32x4 o[2];
#pragma unroll
                    for (int q = 0; q < 2; ++q) { const unsigned bo = 2048u * j + 16u * q + l32; const f32x4 sh = RP_F4(ash, bo) + RP_F4(bsh, bo), sc = RP_F4(asc, bo) + RP_F4(bsc, bo) + 1.0f; o[q] = y[q] * sc + sh; }
                    v4u h; h.x = pkbf(o[0].x, o[0].y); h.y = pkbf(o[0].z, o[0].w); h.z = pkbf(o[1].x, o[1].y); h.w = pkbf(o[1].z, o[1].w); *(GAS v4u*)((GAS char*)hp + (1024u * j + l16)) = h;
                }
                if (j & 1) asm volatile("" ::: "memory");
            }
        }
        if (MODE == 0) {
            const float* ash = ada + (size_t)b * ADAW + seg_sh * D; const float* bsh = bada + seg_sh * D;
            const float* asc = ada + (size_t)b * ADAW + seg_sc * D; const float* bsc = bada + seg_sc * D;
            bf16* hp = H + (size_t)row * D;
#pragma unroll
            for (int j = 0; j < 8; ++j) { f32x4 o[2];
#pragma unroll
                for (int q = 0; q < 2; ++q) { const unsigned bo = 2048u * j + 16u * q + l32; const f32x4 sh = RP_F4(ash, bo) + RP_F4(bsh, bo), sc = RP_F4(asc, bo) + RP_F4(bsc, bo) + 1.0f; o[q] = v[j][q] * sc + sh; }
                v4u w; w.x = pkbf(o[0].x, o[0].y); w.y = pkbf(o[0].z, o[0].w); w.z = pkbf(o[1].x, o[1].y); w.w = pkbf(o[1].z, o[1].w); *(GAS v4u*)((GAS char*)hp + (1024u * j + l16)) = w; if ((j & 3) == 3) asm volatile("" ::: "memory"); }
        }
    }
#undef RP_F4
#undef RP_U4
}

__device__ __forceinline__ void ret_state_unit(int lane, int wave, int bh, int eb, int db, const bf16* KT, const bf16* VT, bf16* RG) {
    const int h = bh & 7, i = lane & 15, g = lane >> 4;
    const int et = eb * 4 + (wave >> 1), dt0 = db * 4 + 2 * (wave & 1);
    const float l2g = pg8::log2_gamma(h);
    const float gam = __builtin_amdgcn_exp2f(l2g), g127 = __builtin_amdgcn_exp2f(127.0f * l2g), g128 = __builtin_amdgcn_exp2f(128.0f * l2g);
    const GAS bf16* KTp = (const GAS bf16*)KT + (size_t)bh * 32 * 32768 + (dt0 * 4) * 512 + lane * 8;
    const GAS bf16* VTp = (const GAS bf16*)VT + (size_t)bh * 32 * 32768 + (et * 4) * 512 + lane * 8;
    GAS bf16* Rp = (GAS bf16*)RG + (size_t)bh * 32 * 65536;
    int roff[2];
#pragma unroll
    for (int t = 0; t < 2; ++t) roff[t] = pg8::frag_off(16 * et + i, 16 * (dt0 + t) + 4 * g, 8);
    f32x4 st[2]; st[0] = (f32x4){0.f, 0.f, 0.f, 0.f}; st[1] = st[0];
    bf16x8 vf[3][4], kt[3][2][4];
#define RS_LOAD(cc, sl) do { const int tn_ = ((cc) < SEQ / CHK ? (cc) : SEQ / CHK - 1) * 32768; \
        _Pragma("unroll") for (int s = 0; s < 4; ++s) vf[sl][s] = *(const GAS bf16x8*)(VTp + tn_ + s * 512); \
        _Pragma("unroll") for (int t = 0; t < 2; ++t) _Pragma("unroll") for (int s = 0; s < 4; ++s) kt[sl][t][s] = *(const GAS bf16x8*)(KTp + tn_ + (t * 4 + s) * 512); } while (0)
    RS_LOAD(0, 0); RS_LOAD(1, 1);
    for (int c3 = 0; c3 < SEQ / CHK; c3 += 3) {
#pragma unroll
        for (int u = 0; u < 3; ++u) {
            const int c = c3 + u;
            if (c >= SEQ / CHK) break;
            RS_LOAD(c + 2, (u + 2) % 3);
#pragma unroll
            for (int t = 0; t < 2; ++t) {
                u32x2 w; w.x = pkbf(gam * st[t][0], gam * st[t][1]); w.y = pkbf(gam * st[t][2], gam * st[t][3]);
                *(GAS u32x2*)(Rp + (size_t)c * 65536 + roff[t]) = w;
                f32x4 tmp = (f32x4){0.f, 0.f, 0.f, 0.f};
#pragma unroll
                for (int s = 0; s < 4; ++s) tmp = MFMA16(kt[u][t][s], vf[u][s], tmp);
                st[t] = st[t] * g128 + tmp * g127;
            }
        }
    }
#undef RS_LOAD
}
__device__ __forceinline__ void ret_out_unit(LAS unsigned char* lds, int tid, int lane, int wave, int bh, int c, const bf16* Q, const bf16* K, const bf16* VT, const bf16* RG, const bf16* GS, bf16* RETG) {
    constexpr int KQ_OFF = 0, KQ_PITCH = 528, PL_OFF = 128 * KQ_PITCH, PL_PITCH = 272, ST_OFF = PL_OFF + 128 * PL_PITCH;
    static_assert(ST_OFF + 128 * 8 * 8 <= RING_BYTES, "retention LDS");
    const int b = bh >> 3, h = bh & 7, i = lane & 15, g = lane >> 4, rb = wave, tok0 = b * SEQ + c * CHK;
    const GAS bf16* Qp = (const GAS bf16*)Q + (size_t)tok0 * RW + 256 * h;
    const GAS bf16* Kp = (const GAS bf16*)K + (size_t)tok0 * RW + 256 * h;
    v4u kreg[8];
#pragma unroll
    for (int q = 0; q < 8; ++q) { const int idx = tid + 512 * q, row = idx >> 5, c16 = idx & 31; kreg[q] = *(const GAS v4u*)(Kp + (size_t)row * RW + c16 * 8); }
    bf16x8 qf[8];
#pragma unroll
    for (int s = 0; s < 8; ++s) qf[s] = *(const GAS bf16x8*)(Qp + (size_t)(16 * rb + i) * RW + 32 * s + 8 * g);
#pragma unroll
    for (int q = 0; q < 8; ++q) { const int idx = tid + 512 * q, row = idx >> 5, c16 = idx & 31; *(LAS v4u*)(lds + KQ_OFF + row * KQ_PITCH + c16 * 16) = kreg[q]; }
    __syncthreads();
#pragma unroll
    for (int q = 0; q < 8; ++q) { const int idx = tid + 512 * q, row = idx >> 5, c16 = idx & 31; kreg[q] = *(const GAS v4u*)(Qp + (size_t)row * RW + c16 * 8); }
    bf16x8 vf[2][4], rf[2][8];
    {
        const GAS bf16* VTp = (const GAS bf16*)VT + ((size_t)bh * 32 + c) * 32768 + (2 * wave * 4) * 512 + lane * 8;
        const GAS bf16* RGp = (const GAS bf16*)RG + ((size_t)bh * 32 + c) * 65536 + (2 * wave * 8) * 512 + lane * 8;
#pragma unroll
        for (int t = 0; t < 2; ++t) {
#pragma unroll
            for (int s = 0; s < 4; ++s) vf[t][s] = *(const GAS bf16x8*)(VTp + (t * 4 + s) * 512);
#pragma unroll
            for (int s = 0; s < 8; ++s) rf[t][s] = *(const GAS bf16x8*)(RGp + (t * 8 + s) * 512);
        }
    }
    for (int j = 0; j <= rb; ++j) {
        f32x4 acc = (f32x4){0.f, 0.f, 0.f, 0.f};
#pragma unroll
        for (int s = 0; s < 8; ++s) { const bf16x8 a = *(const LAS bf16x8*)(lds + KQ_OFF + (16 * j + i) * KQ_PITCH + (32 * s + 8 * g) * 2); acc = MFMA16(a, qf[s], acc); }
        if (j == rb) {
#pragma unroll
            for (int r = 0; r < 4; ++r) if (4 * g + r > i) acc[r] = 0.f;
        }
        u32x2 w; w.x = pkbf(acc[0], acc[1]); w.y = pkbf(acc[2], acc[3]);
        *(LAS u32x2*)(lds + PL_OFF + (16 * rb + i) * PL_PITCH + (16 * j + 4 * g) * 2) = w;
    }
    if ((rb & 1) == 0) { u32x2 z; z.x = 0u; z.y = 0u; *(LAS u32x2*)(lds + PL_OFF + (16 * rb + i) * PL_PITCH + (16 * (rb + 1) + 4 * g) * 2) = z; }
    __syncthreads();
#pragma unroll
    for (int q = 0; q < 8; ++q) { const int idx = tid + 512 * q, row = idx >> 5, c16 = idx & 31; *(LAS v4u*)(lds + KQ_OFF + row * KQ_PITCH + c16 * 16) = kreg[q]; }
    __syncthreads();
    f32x4 o[8][2];
#pragma unroll
    for (int nb = 0; nb < 8; ++nb) {
        o[nb][0] = (f32x4){0.f, 0.f, 0.f, 0.f}; o[nb][1] = o[nb][0];
#pragma unroll
        for (int s = 0; s < 4; ++s) if (s <= (nb >> 1)) {
            const bf16x8 p = *(const LAS bf16x8*)(lds + PL_OFF + (16 * nb + i) * PL_PITCH + (32 * s + 8 * g) * 2);
            o[nb][0] = MFMA16(vf[0][s], p, o[nb][0]); o[nb][1] = MFMA16(vf[1][s], p, o[nb][1]); }
#pragma unroll
        for (int s = 0; s < 8; ++s) {
            const bf16x8 qq = *(const LAS bf16x8*)(lds + KQ_OFF + (16 * nb + i) * KQ_PITCH + (32 * s + 8 * g) * 2);
            o[nb][0] = MFMA16(rf[0][s], qq, o[nb][0]); o[nb][1] = MFMA16(rf[1][s], qq, o[nb][1]); }
    }
    u32x2 gsv[8][2];
    {
        const GAS bf16* gp = (const GAS bf16*)GS + (size_t)(tok0 + i) * RW + 256 * h + 32 * wave + 4 * g;
#pragma unroll
        for (int nb = 0; nb < 8; ++nb)
#pragma unroll
            for (int t = 0; t < 2; ++t) gsv[nb][t] = *(const GAS u32x2*)(gp + (size_t)(16 * nb) * RW + 16 * t);
    }
    LAS f32x2* ST = (LAS f32x2*)(lds + ST_OFF);
#pragma unroll
    for (int nb = 0; nb < 8; ++nb) {
        float s1 = 0.f, s2 = 0.f;
#pragma unroll
        for (int t = 0; t < 2; ++t)
#pragma unroll
            for (int r = 0; r < 4; ++r) { const float v = o[nb][t][r]; s1 += v; s2 += v * v; }
        s1 += __shfl_xor(s1, 16); s1 += __shfl_xor(s1, 32); s2 += __shfl_xor(s2, 16); s2 += __shfl_xor(s2, 32);
        if (g == 0) { f32x2 v; v.x = s1; v.y = s2; ST[(16 * nb + i) * 8 + wave] = v; }
    }
    __syncthreads();
#pragma unroll
    for (int nb = 0; nb < 8; ++nb) {
        float s1 = 0.f, s2 = 0.f;
#pragma unroll
        for (int w = 0; w < 8; ++w) { const f32x2 v = ST[(16 * nb + i) * 8 + w]; s1 += v.x; s2 += v.y; }
        const float mean = s1 * (1.f / HD), var = fmaxf(s2 * (1.f / HD) - mean * mean, 0.f), rstd = 1.0f / sqrtf(var + LN_EPS);
        const size_t rowoff = (size_t)(tok0 + 16 * nb + i) * RW + 256 * h + 32 * wave + 4 * g, outoff = (size_t)(tok0 + 16 * nb + i) * (2 * RW) + 256 * h + 32 * wave + 4 * g;
#pragma unroll
        for (int t = 0; t < 2; ++t) {
            const u32x2 gwv = gsv[nb][t];
            const f32x4 y = (o[nb][t] - mean) * rstd * (f32x4){bflo(gwv.x), bfhi(gwv.x), bflo(gwv.y), bfhi(gwv.y)};
            u32x2 w; w.x = pkbf(y[0], y[1]); w.y = pkbf(y[2], y[3]); *(GAS u32x2*)(RETG + outoff + 16 * t) = w;
        }
    }
    __syncthreads();
}

__device__ __forceinline__ void sg_unit(LAS unsigned char* lds, int tid, int lane, int wave, int ck, int grp, const float* sgw, const float* sgb, const float* lng, const float* lnb,
                                        const float* stats, const bf16* ST, const bf16* UG, bf16* SGU) {
    constexpr int WL_OFF = 0, WL_PITCH = 272, MU_OFF = 128 * WL_PITCH, RS_OFF = MU_OFF + 512, C1_OFF = RS_OFF + 512, C2_OFF = C1_OFF + 512, BS_OFF = C2_OFF + 512;
    const int tok0 = ck * CHK;
    LAS float* MU = (LAS float*)(lds + MU_OFF); LAS float* RS = (LAS float*)(lds + RS_OFF); LAS float* C1 = (LAS float*)(lds + C1_OFF); LAS float* C2 = (LAS float*)(lds + C2_OFF); LAS float* BS = (LAS float*)(lds + BS_OFF);
    const int i = lane & 15, g = lane >> 4;
    const int t = tid >> 2, sq = tid & 3;
    f32x4 sv[4], wv[8];
    {
        const GAS f32x4* sp = (const GAS f32x4*)(stats + (size_t)(tok0 + t) * 64 + 16 * sq);
#pragma unroll
        for (int p = 0; p < 4; ++p) sv[p] = sp[p];
        const GAS f32x4* wp = (const GAS f32x4*)((const GAS float*)sgw + ((size_t)grp * CHK + t) * CHK + 32 * sq);
#pragma unroll
        for (int p = 0; p < 8; ++p) wv[p] = wp[p];
    }
    const float bsv = sgb[grp * CHK + t];
    bf16x8 af[2][4]; f32x4 lgv[2], lbv[2]; u32x2 uwv[8][2];
    const int ch0 = GD * grp + 32 * wave + 4 * g;
    {
        const GAS bf16* spb = (const GAS bf16*)ST + (size_t)ck * 262144 + ((16 * grp + 2 * wave) * 4) * 512 + lane * 8;
#pragma unroll
        for (int tt = 0; tt < 2; ++tt) {
#pragma unroll
            for (int s = 0; s < 4; ++s) af[tt][s] = *(const GAS bf16x8*)(spb + (tt * 4 + s) * 512);
            lgv[tt] = *(const GAS f32x4*)(lng + ch0 + 16 * tt); lbv[tt] = *(const GAS f32x4*)(lnb + ch0 + 16 * tt);
        }
        const GAS bf16* ugp = (const GAS bf16*)UG + (size_t)(tok0 + i) * SGW + ch0;
#pragma unroll
        for (int tb = 0; tb < 8; ++tb)
#pragma unroll
            for (int tt = 0; tt < 2; ++tt) uwv[tb][tt] = *(const GAS u32x2*)(ugp + (size_t)(16 * tb) * SGW + 16 * tt);
    }
    GAS bf16* sgp = (GAS bf16*)SGU + (size_t)(tok0 + i) * (2 * SGW) + ch0;
    {
        float s = 0.f, q = 0.f;
#pragma unroll
        for (int p = 0; p < 4; ++p) { s += sv[p].x + sv[p].z; q += sv[p].y + sv[p].w; }
        s += __shfl_xor(s, 1); s += __shfl_xor(s, 2); q += __shfl_xor(q, 1); q += __shfl_xor(q, 2);
        const float mean = s * (1.f / SGW), var = fmaxf(q * (1.f / SGW) - mean * mean, 0.f);
        if (sq == 0) { MU[t] = mean; RS[t] = 1.0f / sqrtf(var + LN_EPS); }
    }
    __syncthreads();
    {
        float c1 = 0.f, c2 = 0.f;
#pragma unroll
        for (int j = 0; j < 32; j += 2) { const int s = 32 * sq + j; const float w0 = (s <= t) ? wv[j >> 2][j & 3] : 0.f, w1 = (s + 1 <= t) ? wv[j >> 2][(j & 3) + 1] : 0.f;
            const float a0 = w0 * RS[s], a1 = w1 * RS[s + 1]; c2 += w0 + w1; c1 += a0 * MU[s] + a1 * MU[s + 1];
            *(LAS unsigned*)(lds + WL_OFF + t * WL_PITCH + s * 2) = pkbf(a0, a1); }
        c1 += __shfl_xor(c1, 1); c1 += __shfl_xor(c1, 2); c2 += __shfl_xor(c2, 1); c2 += __shfl_xor(c2, 2);
        if (sq == 0) { C1[t] = c1; C2[t] = c2; BS[t] = bsv; }
    }
    __syncthreads();
#pragma unroll
    for (int tb = 0; tb < 8; ++tb) {
        const int trow = 16 * tb + i;
        bf16x8 wf[4];
#pragma unroll
        for (int s = 0; s < 4; ++s) if (s <= (tb >> 1)) wf[s] = *(const LAS bf16x8*)(lds + WL_OFF + trow * WL_PITCH + (32 * s + 8 * g) * 2);
        const float c1t = C1[trow], c2t = C2[trow], bst = BS[trow];
#pragma unroll
        for (int tt = 0; tt < 2; ++tt) {
            f32x4 acc = (f32x4){0.f, 0.f, 0.f, 0.f};
#pragma unroll
            for (int s = 0; s < 4; ++s) if (s <= (tb >> 1)) acc = MFMA16(af[tt][s], wf[s], acc);
            const f32x4 uv = (f32x4){bflo(uwv[tb][tt].x), bfhi(uwv[tb][tt].x), bflo(uwv[tb][tt].y), bfhi(uwv[tb][tt].y)};
            const f32x4 val = uv * (lgv[tt] * (acc - c1t) + lbv[tt] * c2t + bst);
            u32x2 w; w.x = pkbf(val[0], val[1]); w.y = pkbf(val[2], val[3]);
            *(GAS u32x2*)(sgp + (size_t)(16 * tb) * (2 * SGW) + 16 * tt) = w;
        }
    }
    __syncthreads();
}

__global__ void __launch_bounds__(NWAVES * 64, 2) fwd(Args args) {
    extern __shared__ __attribute__((aligned(16))) unsigned char lds_raw[];
    LAS unsigned char* lds = (LAS unsigned char*)lds_raw;
    volatile LAS unsigned* MISC = (volatile LAS unsigned*)(lds + MISC_OFF);
    const int tid = threadIdx.x, lane = tid & 63, wave = __builtin_amdgcn_readfirstlane(tid >> 6);
    const int G = gridDim.x, bx = blockIdx.x, vcu = (G % 8 == 0) ? (bx % 8) * (G / 8) + bx / 8 : bx;
    const int gw = vcu * NWAVES + wave, NGW = G * NWAVES;
    unsigned char* ws = args.ws;
    unsigned* ctl = (unsigned*)(ws + WS_CTL);
    const float* x = args.in[0]; const float* cin = args.in[1]; const int* pos = (const int*)args.in[2]; const float* w_ada = args.in[3]; const float* b_ada = args.in[4];
    const float* w_in = args.in[5]; const float* sg_ln_g = args.in[6]; const float* sg_ln_b = args.in[7]; const float* sg_w = args.in[8]; const float* sg_b = args.in[9];
    const float* w_ret_up = args.in[10]; const float* w_sg_up = args.in[11]; const float* w_out = args.in[12]; const float* ln1_g = args.in[13]; const float* ln1_b = args.in[14];
    const float* w_gate_up = args.in[15]; const float* w_down = args.in[16]; const float* ln2_g = args.in[17]; const float* ln2_b = args.in[18];
    float* ada = (float*)(ctl + CW_ADA);
    float* cosT = (float*)(ws + WS_COS); float* sinT = (float*)(ws + WS_SIN); float* stats = (float*)(ws + WS_STATS);
    bf16 *WIN = (bf16*)(ws + WS_WIN), *WRET = (bf16*)(ws + WS_WRET), *WSG = (bf16*)(ws + WS_WSG), *WOUT = (bf16*)(ws + WS_WOUT), *WGU = (bf16*)(ws + WS_WGU), *WDN = (bf16*)(ws + WS_WDN);
    bf16 *H = (bf16*)(ws + WS_H), *Qb = (bf16*)(ws + WS_Q), *Kb = (bf16*)(ws + WS_K), *KTb = (bf16*)(ws + WS_KT), *VTb = (bf16*)(ws + WS_VT), *GSb = (bf16*)(ws + WS_GS), *UGb = (bf16*)(ws + WS_UG), *STb = (bf16*)(ws + WS_ST);
    bf16 *SIGR = (bf16*)(ws + WS_SIGR), *SIGS = (bf16*)(ws + WS_SIGS), *RETG = (bf16*)(ws + WS_RETG), *SGU = (bf16*)(ws + WS_RETG) + RW, *MIX = (bf16*)(ws + WS_MIX), *ACT = (bf16*)(ws + WS_ACT);
    bf16* RGb = (bf16*)(ws + WS_RET);
    float* PRE = (float*)(ws + WS_PRE);
    bf16 *PREb = (bf16*)(ws + WS_X1), *X1b = (bf16*)(ws + WS_X1 + 64 * MiB);

    for (int u = tid; u < (LDS_BYTES - LDSCTL_OFF) / 4; u += NWAVES * 64) ((LAS unsigned*)(lds + LDSCTL_OFF))[u] = 0u;
    __syncthreads();
    XcdBarrier bar; bar.bar = ctl + CW_BAR; bar.x = 0; bar.st = nullptr;
    if (MK_N_LAUNCHES == 1) bar = xcd_barrier_post(ctl + CW_BAR, MISC + 8);
    const int lo = args.ph_lo, hi = args.ph_hi;
#if defined(GP_STAMP) || defined(PH_STAMP)
    unsigned long long* prb = (unsigned long long*)(ctl + 32768);
    unsigned long long gp_prev = __builtin_amdgcn_s_memrealtime(); const unsigned long long gp_t0 = gp_prev;
#define PSTAMP(k) do { if (bx == 0 && tid == 0) { const unsigned long long now_ = __builtin_amdgcn_s_memrealtime(); prb[64 + (k)] = now_ - gp_prev; gp_prev = now_; } } while (0)
#ifdef GP_STAMP
#define SPRB(k) S.prb = prb + 4 * (k);
#else
#define SPRB(k)
#endif
#else
#define PSTAMP(k) do {} while (0)
#define SPRB(k)
#endif
#ifndef PH_MASK
#ifdef DBG_STOP
#define PH_MASK (((2u << DBG_STOP) - 1u) | 0x800u)
#else
#define PH_MASK 0xfff
#endif
#endif
#define IN(k) (((PH_MASK >> (k)) & 1) && lo <= (k) && (k) < hi)
#define SEAM(k) do { if (IN(k) && IN((k) + 1)) xcd_barrier(bar); PSTAMP(k); } while (0)
#ifndef DUP_MASK
#define DUP_MASK 0
#endif
#define REP(k) for (int rep_ = 0; rep_ < (((DUP_MASK >> (k)) & 1) ? 2 : 1); ++rep_)

    if (IN(0)) REP(0) {
        LAS float* scl = (LAS float*)(lds + RING_OFF);
        for (int u = tid; u < BATCH * D; u += NWAVES * 64) { const float v = cin[u]; scl[u] = v / (1.0f + expf(-v)); }
        __syncthreads();
#ifndef DUP_P0
#define DUP_P0 0
#endif
        for (int rr0 = 0; rr0 < ((DUP_P0 & 1) ? 2 : 1); ++rr0)
        for (int cb = vcu; cb < ADAW / 96; cb += G) {
            const int half = lane / 24, c4 = lane - 24 * half;
            f32x4 a0 = (f32x4){0.f, 0.f, 0.f, 0.f}, a1 = a0;
            if (lane < 48) {
                const GAS float* wp = (const GAS float*)w_ada + (size_t)(512 * wave + half) * ADAW + cb * 96 + 4 * c4;
#pragma unroll 8
                for (int kk = 0; kk < 256; ++kk) { const f32x4 w = *(const GAS f32x4*)(wp + (size_t)(2 * kk) * ADAW); const int k = 512 * wave + 2 * kk + half; const float s0 = scl[k], s1 = scl[D + k]; a0 += w * s0; a1 += w * s1; }
            }
            LAS f32x4* red = (LAS f32x4*)(lds + RING_OFF + 32768);
            if (lane < 48) { red[(wave * 48 + lane) * 2] = a0; red[(wave * 48 + lane) * 2 + 1] = a1; }
            __syncthreads();
            if (tid < 48) {
                const int bsel = tid / 24, cc = tid - 24 * bsel; f32x4 s = (f32x4){0.f, 0.f, 0.f, 0.f};
#pragma unroll
                for (int w = 0; w < 8; ++w) { s += red[(w * 48 + cc) * 2 + bsel]; s += red[(w * 48 + 24 + cc) * 2 + bsel]; }
                *(GAS f32x4*)(ada + (size_t)bsel * ADAW + cb * 96 + 4 * cc) = s;
            }
            __syncthreads();
        }
        for (int rr1 = 0; rr1 < ((DUP_P0 & 2) ? 2 : 1); ++rr1)
        {
            constexpr int I0 = (D / 64) * (INW / 64), I1 = (RW / 64) * (D / 64), I2 = I1, I3 = (D / 64) * (D / 64), I4 = (D / 64) * (2 * DFF / 64), I5 = (DFF / 64) * (D / 64);
            constexpr int NIT = I0 + I1 + I2 + I3 + I4 + I5;
            LAS unsigned char* tscr = lds + RING_OFF + 49152 + wave * 9216;
            for (int it = gw; it < NIT; it += NGW) {
                int r = it;
#ifdef TR_NFAST
#define TR_KB(r, KB, NB) ((r) / (NB))
#define TR_NB(r, KB, NB) ((r) % (NB))
#else
#define TR_KB(r, KB, NB) ((r) % (KB))
#define TR_NB(r, KB, NB) ((r) / (KB))
#endif
                if (r < I0) { const int kb = TR_KB(r, D / 64, INW / 64), n0 = TR_NB(r, D / 64, INW / 64) * 64; p0_transpose_item(w_in, D, INW, WIN, kb, n0, n0, lane, tscr); continue; } r -= I0;
                if (r < I1) { const int kb = TR_KB(r, RW / 64, D / 64), n0 = TR_NB(r, RW / 64, D / 64) * 64; p0_transpose_item(w_ret_up, RW, D, WRET, kb, n0, n0, lane, tscr, 2 * RW, 0); continue; }   r -= I1;
                if (r < I2) { const int kb = TR_KB(r, SGW / 64, D / 64), n0 = TR_NB(r, SGW / 64, D / 64) * 64; p0_transpose_item(w_sg_up, SGW, D, WRET, kb, n0, n0, lane, tscr, 2 * RW, RW); continue; } r -= I2;
                if (r < I3) { const int kb = TR_KB(r, D / 64, D / 64), n0 = TR_NB(r, D / 64, D / 64) * 64; p0_transpose_item(w_out, D, D, WOUT, kb, n0, n0, lane, tscr); continue; } r -= I3;
                if (r < I4) { const int kb = TR_KB(r, D / 64, 2 * DFF / 64), n0 = TR_NB(r, D / 64, 2 * DFF / 64) * 64; p0_transpose_item(w_gate_up, D, 2 * DFF, WGU, kb, n0, gu_row0(n0), lane, tscr); continue; } r -= I4;
                { const int kb = TR_KB(r, DFF / 64, D / 64), n0 = TR_NB(r, DFF / 64, D / 64) * 64; p0_transpose_item(w_down, DFF, D, WDN, kb, n0, n0, lane, tscr); }
            }
        }
        for (int rr2 = 0; rr2 < ((DUP_P0 & 4) ? 2 : 1); ++rr2)
        for (int e = (vcu * NWAVES * 64 + tid); e < M * 128; e += G * NWAVES * 64) {
            const int row = e >> 7, j = e & 127;
            const float inv = (float)exp2(-(double)j * (13.287712379549449 / 128.0));
            const float angf = (float)pos[row] * inv;
            const double a = (double)angf; const double rr = a - 6.283185307179586476925 * rint(a * 0.15915494309189533577);
            cosT[e] = cosf((float)rr); sinT[e] = sinf((float)rr);
        }
        __syncthreads();
    }
    SEAM(0);
    if (IN(1)) REP(1) row_pass<0>(gw, NGW, lane, x, nullptr, nullptr, nullptr, nullptr, H, ada, b_ada, 0, 1);
    SEAM(1);
    if (IN(2)) REP(2) {
        pg8::Gemm g{H, WIN, M, INW, D}; pg8::StaticOrder S; S.init(M, INW, G, bx); SPRB(2)
        pg8::EpiZ E{ws, stats, cosT, sinT};
        pg8::gemm_phase<pg8::EpiZ, pg8::StaticOrder, GP_ALIGN, GP_SP2>(lds + RING_OFF, g, S, E);
    }
    SEAM(2);
    if (IN(3)) REP(3) {
#ifndef DUP_SUB
#define DUP_SUB 0
#endif
        for (int rr = 0; rr < ((DUP_SUB & 1) ? 2 : 1); ++rr)
        for (int u0 = vcu; u0 < 256; u0 += G) { const int uid = (u0 + 100 * rr) & 255; ret_state_unit(lane, wave, uid >> 4, (uid >> 2) & 3, uid & 3, KTb, VTb, RGb); }
#if defined(PH_STAMP)
        if (bx == 0 && tid == 0) prb[90] = __builtin_amdgcn_s_memrealtime() - gp_prev;
#endif
        for (int rr = 0; rr < ((DUP_SUB & 2) ? 2 : 1); ++rr)
        for (int u0 = vcu; u0 < 512; u0 += G) { const int uid = (u0 + 200 * rr) & 511; sg_unit(lds + RING_OFF, tid, lane, wave, uid >> 3, uid & 7, sg_w, sg_b, sg_ln_g, sg_ln_b, stats, STb, UGb, SGU); }
    }
#if defined(PH_STAMP)
    if (IN(3) && bx == 0 && tid == 0) prb[91] = __builtin_amdgcn_s_memrealtime() - gp_prev;
#endif
    SEAM(3);
    if (IN(4)) REP(4) {
        for (int u0 = vcu; u0 < 512; u0 += G) { const int uid = (u0 + 200 * rep_) & 511; ret_out_unit(lds + RING_OFF, tid, lane, wave, uid >> 5, uid & 31, Qb, Kb, VTb, RGb, GSb, RETG); }
    }
    SEAM(4);
    if (IN(5)) REP(5) {
        pg8::Gemm g{RETG, WRET, M, D, 2 * RW}; pg8::StaticOrder S; S.init(M, D, G, bx); SPRB(5)
        pg8::EpiMixCat E{SIGR, SIGS, MIX, D};
        pg8::gemm_phase<pg8::EpiMixCat, pg8::StaticOrder, GP_ALIGN, GP_SP2>(lds + RING_OFF, g, S, E);
    }
    SEAM(5);
    if (IN(7)) REP(7) {
        pg8::Gemm g{MIX, WOUT, M, D, D}; pg8::StaticOrder S; S.init(M, D, G, bx); SPRB(7)
        pg8::EpiRes<false> E{x, PREb, D, ada + 2 * D, b_ada + 2 * D, ADAW, SEQ, ALPHA};
        pg8::gemm_phase<pg8::EpiRes<false>, pg8::StaticOrder, GP_ALIGN, GP_SP2>(lds + RING_OFF, g, S, E);
    }
    SEAM(7);
    if (IN(8)) REP(8) row_pass<1>(gw, NGW, lane, PREb, ln1_g, ln1_b, nullptr, X1b, H, ada, b_ada, 3, 4);
    SEAM(8);
#ifdef PROBE_NULL9
    if (IN(9)) {
        pg8::Gemm g{H, WGU, M, 2 * DFF, D}; pg8::StaticOrder S; S.init(M, 2 * DFF, G, bx);
        pg8::EpiNull E{(float*)(ws + WS_STATS)};
        pg8::gemm_phase<pg8::EpiNull, pg8::StaticOrder, GP_ALIGN, GP_SP2>(lds + RING_OFF, g, S, E);
    }
#endif
    if (IN(9)) REP(9) {
        pg8::Gemm g{H, WGU, M, 2 * DFF, D}; pg8::StaticOrder S; S.init(M, 2 * DFF, G, bx); SPRB(9)
        pg8::EpiSwiGLU E{ACT, DFF};
        pg8::gemm_phase<pg8::EpiSwiGLU, pg8::StaticOrder, GP_ALIGN, GP_SP2>(lds + RING_OFF, g, S, E);
    }
    SEAM(9);
    if (IN(10)) REP(10) {
        pg8::Gemm g{ACT, WDN, M, D, DFF}; pg8::StaticOrder S; S.init(M, D, G, bx); SPRB(10)
        pg8::EpiRes<true> E{X1b, PREb, D, ada + 5 * D, b_ada + 5 * D, ADAW, SEQ, ALPHA};
        pg8::gemm_phase<pg8::EpiRes<true>, pg8::StaticOrder, GP_ALIGN, GP_SP2>(lds + RING_OFF, g, S, E);
    }
    SEAM(10);
#ifndef DBG_STOP
    if (IN(11)) REP(11) row_pass<2>(gw, NGW, lane, PREb, ln2_g, ln2_b, args.out, nullptr, nullptr, nullptr, nullptr, 0, 0);
#else
    if (IN(11)) {
        const size_t NT = (size_t)G * NWAVES * 64, NE = (size_t)M * D, HN = (size_t)M * 2048;
        for (size_t e = (size_t)vcu * NWAVES * 64 + tid; e < NE; e += NT) {
            float s = 0.f; const size_t eh = e % HN;
            if (DBG_STOP == 1) { s = bflo((unsigned)H[e]) ; }
            if (DBG_STOP == 0) { s = bflo((unsigned)WIN[e]) + bflo((unsigned)WIN[e + NE]) + bflo((unsigned)WGU[e]) + bflo((unsigned)WGU[e + NE]) + bflo((unsigned)WDN[e]) + bflo((unsigned)WOUT[e % ((size_t)D * D)]) + bflo((unsigned)WRET[eh % ((size_t)D * RW)]) + bflo((unsigned)WSG[eh % ((size_t)D * RW)]) + cosT[e % ((size_t)M * 128)] + sinT[e % ((size_t)M * 128)] + ada[e % (2 * ADAW)]; }
            if (DBG_STOP == 2) { s = bflo((unsigned)Qb[eh]) + bflo((unsigned)Kb[eh]) + bflo((unsigned)KTb[eh]) + bflo((unsigned)VTb[eh]) + bflo((unsigned)GSb[eh]) + bflo((unsigned)UGb[eh]) + bflo((unsigned)STb[eh]) + bflo((unsigned)SIGR[e]) + bflo((unsigned)SIGS[e]) + stats[e % ((size_t)M * 64)]; }
#ifndef DBG_P3
#define DBG_P3 3
#endif
            if (DBG_STOP == 3) { s = ((DBG_P3 & 1) ? bflo((unsigned)RGb[e]) : 0.f) + ((DBG_P3 & 2) ? bflo((unsigned)RETG[e]) : 0.f); }
            if (DBG_STOP == 4) { s = bflo((unsigned)RETG[e]); }
            if (DBG_STOP == 6) { s = bflo((unsigned)MIX[e]); }
            if (DBG_STOP == 7) { s = bflo((unsigned)PREb[e]); }
            if (DBG_STOP == 8) { s = bflo((unsigned)X1b[e]) + bflo((unsigned)H[e]); }
            if (DBG_STOP == 9) { s = bflo((unsigned)ACT[e]) + bflo((unsigned)ACT[e + NE]); }
            if (DBG_STOP == 10) { s = bflo((unsigned)PREb[e]); }
            args.out[e] = s;
        }
    }
#endif
#if defined(GP_STAMP) || defined(PH_STAMP)
    PSTAMP(11);
    if (bx == 0 && tid == 0) prb[80] = __builtin_amdgcn_s_memrealtime() - gp_t0;
    if (bx == 0 && tid == 0 && IN(11)) { const unsigned long long t_end = __builtin_amdgcn_s_memrealtime() + (unsigned long long)PRB_AMP * prb[PRB_A];
        while (__builtin_amdgcn_s_memrealtime() < t_end) __builtin_amdgcn_s_sleep(16); }
#endif
#undef IN
#undef SEAM
}

extern "C" void kernel_launch(void* const* d_in, const int* in_sizes, int n_in, void* d_out, int out_size, void* d_ws, size_t ws_size, hipStream_t stream) {
    static int grid = 0;
    if (grid == 0) {
        if (n_in != 19 || in_sizes[0] != M * D || out_size != M * D || ws_size < WS_END) { fprintf(stderr, "kernel_launch: unexpected shapes (n_in %d, in0 %d, out %d, ws %zu)\n", n_in, n_in > 0 ? in_sizes[0] : -1, out_size, ws_size); grid = -1; return; }
        int dev = 0, cus = 0, per_cu = 0;
        if (hipGetDevice(&dev) != hipSuccess || hipDeviceGetAttribute(&cus, hipDeviceAttributeMultiprocessorCount, dev) != hipSuccess) { grid = -1; return; }
        if (hipFuncSetAttribute((const void*)fwd, hipFuncAttributeMaxDynamicSharedMemorySize, LDS_BYTES) != hipSuccess) { fprintf(stderr, "kernel_launch: hipFuncSetAttribute failed\n"); grid = -1; return; }
        if (hipOccupancyMaxActiveBlocksPerMultiprocessor(&per_cu, (const void*)fwd, NWAVES * 64, LDS_BYTES) != hipSuccess || per_cu < 1) fprintf(stderr, "kernel_launch: occupancy query reports %d\n", per_cu);
        (void)hipGetLastError();
        grid = cus;
    }
    if (grid < 0) return;
    if (hipMemsetAsync((char*)d_ws + WS_CTL, 0, CTL_ZERO_BYTES, stream) != hipSuccess) { fprintf(stderr, "kernel_launch: memset failed\n"); return; }
#ifdef PROBE_MEMSET2
    (void)hipMemsetAsync((char*)d_ws + WS_CTL, 0, CTL_ZERO_BYTES, stream);
#endif
    Args a{};
    for (int i = 0; i < 19; ++i) a.in[i] = (const float*)d_in[i];
    a.out = (float*)d_out; a.ws = (unsigned char*)d_ws;
    if (MK_N_LAUNCHES == 1) { a.ph_lo = 0; a.ph_hi = N_PHASES + 1; hipLaunchKernelGGL(fwd, dim3(grid), dim3(NWAVES * 64), LDS_BYTES, stream, a); }
    else for (int p = 0; p <= N_PHASES; ++p) { a.ph_lo = p; a.ph_hi = p + 1; hipLaunchKernelGGL(fwd, dim3(grid), dim3(NWAVES * 64), LDS_BYTES, stream, a); }
    const hipError_t le = hipPeekAtLastError();
    if (le != hipSuccess) fprintf(stderr, "kernel_launch: launch failed: %s\n", hipGetErrorName(le));
}
```
